# Optimizing an MI355X kernel written in HIP

```python
import math
import jax, jax.numpy as jnp
from jax import lax
import numpy as np

D_MODEL = 1024
BATCH = 1
SEQ = 16384
DEPTH = 1

CHUNK = 64
MEM_LEN = 256
HEAD_DIM = 64
POOL_WINDOWS = (2, 4, 8, 16)
POOL_GROUPS = len(POOL_WINDOWS)
POOL_GROUP_DIM = 64
POOL_WIDTH = POOL_GROUPS * POOL_GROUP_DIM
ATTN_HEADS = 8
ATTN_WIDTH = ATTN_HEADS * HEAD_DIM
BAND_CHUNKS = 9
BAND_KEYS = BAND_CHUNKS * CHUNK
MAX_REL = 128
MEM_HEADS = 4
MEM_WIDTH = MEM_HEADS * HEAD_DIM
N_BRANCH = 3
IN_COLS = POOL_WIDTH + 3 * ATTN_WIDTH + MEM_WIDTH + N_BRANCH * D_MODEL
D_FF = 2816
CONV_WIDTH = 3
RMS_EPS = 1e-6
NEG_INF = -1e30

kernel_name = "hybrid_pool_chunkattn_mem_convffn"


def rms_norm(x, g):
    xf = x.astype(jnp.float32)
    y = xf * lax.rsqrt(jnp.mean(xf * xf, axis=-1, keepdims=True) + RMS_EPS)
    return (y * g.astype(jnp.float32)).astype(x.dtype)


def pool_mixer(u, w_pool, pool_scale):
    B, S, _ = u.shape
    ug = u.reshape(B, S, POOL_GROUPS, POOL_GROUP_DIM)
    pos1 = jnp.arange(1, S + 1, dtype=jnp.int32)
    outs = []
    for g, w in enumerate(POOL_WINDOWS):
        ui = ug[:, :, g].astype(jnp.float32)
        c = jnp.cumsum(ui, axis=1)
        c_prev = jnp.pad(c, ((0, 0), (w, 0), (0, 0)))[:, :S]
        cnt = jnp.minimum(pos1, w).astype(jnp.float32)[None, :, None]
        outs.append((c - c_prev) / cnt - ui)
    p = jnp.stack(outs, axis=2).astype(u.dtype)
    y = jnp.einsum('bsgc,gcd->bsgd', p, w_pool)
    return y.reshape(B, S, POOL_WIDTH) * pool_scale


def chunk_band_attention(q, k, v, rel_bias):
    B, S, _ = q.shape
    NC = S // CHUNK
    shp = (B, NC, CHUNK, ATTN_HEADS, HEAD_DIM)
    q, k, v = q.reshape(shp), k.reshape(shp), v.reshape(shp)
    pad = ((0, 0), (BAND_CHUNKS - 1, 0), (0, 0), (0, 0), (0, 0))
    kp, vp = jnp.pad(k, pad), jnp.pad(v, pad)
    kb = jnp.stack([kp[:, j:j + NC] for j in range(BAND_CHUNKS)], axis=2).reshape(B, NC, BAND_KEYS, ATTN_HEADS, HEAD_DIM)
    vb = jnp.stack([vp[:, j:j + NC] for j in range(BAND_CHUNKS)], axis=2).reshape(B, NC, BAND_KEYS, ATTN_HEADS, HEAD_DIM)
    s = jnp.einsum('bnqhd,bnkhd->bnhqk', q, kb, preferred_element_type=jnp.float32) * (HEAD_DIM ** -0.5)
    qi = jnp.arange(CHUNK)
    kj = jnp.arange(BAND_KEYS)
    rel = qi[:, None] + (BAND_CHUNKS - 1) * CHUNK - kj[None, :]
    idx = jnp.clip(rel, -MAX_REL, MAX_REL) + MAX_REL
    bias = rel_bias[:, idx].astype(jnp.float32)
    s = s + bias[None, None]
    valid = (jnp.arange(NC)[:, None] - (BAND_CHUNKS - 1) + kj[None, :] // CHUNK) >= 0
    s = jnp.where(valid[None, :, None, None, :], s, NEG_INF)
    p = jax.nn.softmax(s, axis=-1).astype(v.dtype)
    o = jnp.einsum('bnhqk,bnkhd->bnqhd', p, vb)
    return o.reshape(B, S, ATTN_WIDTH)


def memory_attention(q, mem_n, w_mem_kv):
    B, S, _ = q.shape
    M = mem_n.shape[1]
    kv = (mem_n @ w_mem_kv).reshape(B, M, 2, MEM_HEADS, HEAD_DIM)
    km, vm = kv[:, :, 0], kv[:, :, 1]
    qh = q.reshape(B, S, MEM_HEADS, HEAD_DIM)
    s = jnp.einsum('bshd,bmhd->bhsm', qh, km, preferred_element_type=jnp.float32) * (HEAD_DIM ** -0.5)
    p = jax.nn.softmax(s, axis=-1).astype(vm.dtype)
    o = jnp.einsum('bhsm,bmhd->bshd', p, vm)
    return o.reshape(B, S, MEM_WIDTH)


def conv_gated_mlp(h, w_up, conv_w, conv_b, w_down):
    S = h.shape[1]
    a = h @ w_up
    ap = jnp.pad(a, ((0, 0), (CONV_WIDTH - 1, 0), (0, 0)))
    c = conv_b + sum(ap[:, t:t + S] * conv_w[t] for t in range(CONV_WIDTH))
    gate, val = c[..., :D_FF], c[..., D_FF:]
    return (jax.nn.gelu(gate, approximate=False) * val) @ w_down


def setup_inputs(seed: int = 0) -> dict:
    key = jax.random.key(seed)
    ks = jax.random.split(key, 24)
    f32 = jnp.float32
    nrm = lambda k, shape, fan_in: jax.random.normal(k, shape, f32) * (fan_in ** -0.5)
    gain = lambda k, shape: 1.0 + 0.05 * jax.random.normal(k, shape, f32)
    L = DEPTH
    return {
        "x": jax.random.normal(ks[0], (BATCH, SEQ, D_MODEL), f32),
        "mem": jax.random.normal(ks[1], (BATCH, MEM_LEN, D_MODEL), f32),
        "norm_mix_g": gain(ks[2], (L, D_MODEL)),
        "norm_mem_g": gain(ks[3], (L, D_MODEL)),
        "w_in": nrm(ks[4], (L, D_MODEL, IN_COLS), D_MODEL),
        "b_gate": 0.02 * jax.random.normal(ks[5], (L, N_BRANCH * D_MODEL), f32),
        "w_pool": nrm(ks[6], (L, POOL_GROUPS, POOL_GROUP_DIM, POOL_GROUP_DIM), POOL_GROUP_DIM),
        "pool_scale": gain(ks[7], (L, POOL_WIDTH)),
        "rel_bias": 0.5 * jax.random.normal(ks[8], (L, ATTN_HEADS, 2 * MAX_REL + 1), f32),
        "w_mem_kv": nrm(ks[9], (L, D_MODEL, 2 * MEM_WIDTH), D_MODEL),
        "w_up_pool": nrm(ks[10], (L, POOL_WIDTH, D_MODEL), POOL_WIDTH),
        "w_up_attn": nrm(ks[11], (L, ATTN_WIDTH, D_MODEL), ATTN_WIDTH),
        "w_up_mem": nrm(ks[12], (L, MEM_WIDTH, D_MODEL), MEM_WIDTH),
        "w_out": nrm(ks[13], (L, D_MODEL, D_MODEL), D_MODEL),
        "norm_ffn_g": gain(ks[14], (L, D_MODEL)),
        "w_ffn_up": nrm(ks[15], (L, D_MODEL, 2 * D_FF), D_MODEL),
        "conv_w": nrm(ks[16], (L, CONV_WIDTH, 2 * D_FF), CONV_WIDTH),
        "conv_b": 0.02 * jax.random.normal(ks[17], (L, 2 * D_FF), f32),
        "w_ffn_down": nrm(ks[18], (L, D_FF, D_MODEL), D_FF),
        "norm_final_g": gain(ks[19], (D_MODEL,)),
    }


def reference(x, mem, norm_mix_g, norm_mem_g, w_in, b_gate, w_pool, pool_scale, rel_bias,
              w_mem_kv, w_up_pool, w_up_attn, w_up_mem, w_out, norm_ffn_g, w_ffn_up,
              conv_w, conv_b, w_ffn_down, norm_final_g):
    B, S, D = x.shape
    o1 = POOL_WIDTH
    o2 = o1 + ATTN_WIDTH
    o3 = o2 + ATTN_WIDTH
    o4 = o3 + ATTN_WIDTH
    o5 = o4 + MEM_WIDTH
    for l in range(DEPTH):
        h = rms_norm(x, norm_mix_g[l])
        z = h @ w_in[l]
        u_pool = z[..., :o1]
        q_a, k_a, v_a = z[..., o1:o2], z[..., o2:o3], z[..., o3:o4]
        q_m = z[..., o4:o5]
        gates = jax.nn.sigmoid(z[..., o5:] + b_gate[l]).reshape(B, S, N_BRANCH, D)

        y_pool = pool_mixer(u_pool, w_pool[l], pool_scale[l]) @ w_up_pool[l]
        y_attn = chunk_band_attention(q_a, k_a, v_a, rel_bias[l]) @ w_up_attn[l]
        mem_n = rms_norm(mem, norm_mem_g[l])
        y_mem = memory_attention(q_m, mem_n, w_mem_kv[l]) @ w_up_mem[l]

        merged = gates[:, :, 0] * y_pool + gates[:, :, 1] * y_attn + gates[:, :, 2] * y_mem
        x = x + merged @ w_out[l]

        h2 = rms_norm(x, norm_ffn_g[l])
        x = x + conv_gated_mlp(h2, w_ffn_up[l], conv_w[l], conv_b[l], w_ffn_down[l])
    return rms_norm(x, norm_final_g)
```

```cpp
#include <hip/hip_runtime.h>
#include <hip/hip_cooperative_groups.h>
#include <cstdio>
#include <cstdint>
namespace cg = cooperative_groups;

#define DI __device__ __forceinline__
#define LAS __attribute__((address_space(3)))
typedef unsigned short bf16_t;
typedef short bf16x8 __attribute__((ext_vector_type(8)));
typedef short s16x4 __attribute__((ext_vector_type(4)));
typedef float f32x2 __attribute__((ext_vector_type(2)));
typedef float f32x4 __attribute__((ext_vector_type(4)));
typedef float f32x16 __attribute__((ext_vector_type(16)));
typedef unsigned u32x2 __attribute__((ext_vector_type(2)));
typedef unsigned u32x4 __attribute__((ext_vector_type(4)));
typedef __bf16 bf16x2_t __attribute__((ext_vector_type(2)));

constexpr int S = 16384, D = 1024, DFF = 2816, NIN = 5120, NWAVES = 8;
constexpr float EPS = 1e-6f, LOG2E = 1.4426950408889634f, QSCALE = 0.125f * LOG2E;
constexpr int QKU_P = 1536, GATE_P = 3072;
constexpr size_t MiB = 1u << 20;
constexpr size_t WS_WIN = 0, WS_WUP = 10 * MiB, WS_WOUT = 12 * MiB, WS_WFUP = 14 * MiB, WS_WDN = 25 * MiB;
constexpr size_t WS_KM = 31 * MiB, WS_VMT = WS_KM + 131072, WS_PART = WS_VMT + 131072, WS_PART2 = WS_PART + MiB;
constexpr size_t WS_BAR = WS_PART2 + MiB;
constexpr size_t WS_R1 = 34 * MiB;
constexpr size_t WS_QKU = 67 * MiB, WS_GATES = 115 * MiB, WS_VT = 211 * MiB, WS_END = 227 * MiB;
constexpr size_t WS_MERGED = WS_QKU, WS_ACT = WS_QKU;
constexpr int LDS_RING = 131072, LDS_BIAS = LDS_RING, LDS_BYTES = 147456;

DI unsigned pk2(float lo, float hi) { f32x2 v = {lo, hi}; bf16x2_t b = __builtin_convertvector(v, bf16x2_t); return __builtin_bit_cast(unsigned, b); }
DI float bflo(unsigned u) { return __builtin_bit_cast(float, u << 16); }
DI float bfhi(unsigned u) { return __builtin_bit_cast(float, u & 0xffff0000u); }
DI float wave_sum(float v) {
#pragma unroll
    for (int o = 1; o < 64; o <<= 1) v += __shfl_xor(v, o);
    return v;
}
DI int lane_id_v() { int l; asm volatile("v_mbcnt_lo_u32_b32 %0, -1, 0\n\tv_mbcnt_hi_u32_b32 %0, -1, %0" : "=v"(l)); return l; }
DI float dpp_shr1(float v) { float r; asm volatile("s_nop 1\n\tv_mov_b32_dpp %0, %1 row_shr:1 row_mask:0xf bank_mask:0xf bound_ctrl:1\n\ts_nop 1" : "=&v"(r) : "v"(v)); return r; }
DI f32x2 gelu_pk(f32x2 v) {
    const f32x2 av = __builtin_elementwise_abs(v), d = av * 0.2316418882f + 1.0f;
    f32x2 t; t.x = __builtin_amdgcn_rcpf(d.x); t.y = __builtin_amdgcn_rcpf(d.y);
    f32x2 q = t * 0.5307027145f + (-0.7265760135f); q = q * t + 0.7107068705f; q = q * t + (-0.142248368f); q = q * t + 0.127414796f; q = q * t;
    const f32x2 s = (v * v) * (-0.72134752044f);
    f32x2 e; e.x = __builtin_amdgcn_exp2f(s.x); e.y = __builtin_amdgcn_exp2f(s.y);
    const f32x2 m = v * (q * e), r = v - m;
    f32x2 o; o.x = v.x < 0.f ? m.x : r.x; o.y = v.y < 0.f ? m.y : r.y; return o;
}

namespace pg8 {
constexpr int BM = 256, BK = 64, HALF = 128, HTB = HALF * BK * 2, NXCD = 8, WGM = 8;
DI int lds_byte(int r, int c) { const int st = (r >> 4) * 2 + (c >> 5), rr = r & 15, cc = c & 31, ob = rr * 64 + cc * 2; return st * 1024 + (ob ^ (((ob >> 9) & 1) << 5)); }
DI void stage_rc(int b, int& R, int& C) { const int st = b / 1024, sb = b % 1024, swz = sb ^ (((sb >> 9) & 1) << 5); R = (st >> 1) * 16 + swz / 64; C = (st & 1) * 32 + (swz % 64) / 2; }
DI int perm32(int rho) { const int n = rho >> 4, i = rho & 15; return 8 * (i >> 2) + 4 * n + (i & 3); }
struct Unit { int pm, pn; };
struct Gemm { const bf16_t* A; const bf16_t* Bt; int K; size_t a_tstep, a_hstep, b_tstep, b_hstep; };
struct StaticOrder {
    int nM, nN, nwg, G, c;
    DI void init(int nM_, int nN_, int G_, int c_) { nM = nM_; nN = nN_; nwg = nM * nN; G = G_; c = c_; }
    DI bool next(int i, Unit& u) const {
        const long L = (long)i * G + c; if (L >= nwg) return false;
        int wgid = (int)L; { const int q = nwg / NXCD, r = nwg % NXCD, xcd = wgid % NXCD, off = wgid / NXCD; wgid = (xcd < r ? xcd * (q + 1) : r * (q + 1) + (xcd - r) * q) + off; }
        const int nig = WGM * nN, gid = wgid / nig, fm = gid * WGM, gsz = (nM - fm) < WGM ? (nM - fm) : WGM;
        u.pm = fm + ((wgid % nig) % gsz); u.pn = (wgid % nig) / gsz; return true;
    }
};
template <class Epi, class Sched>
DI void gemm_phase(LAS unsigned char* lds, const Gemm g, const Sched& S, const Epi& E, const int wid) {
    const int lane = lane_id_v();
    const int tid = wid * 64 + lane, wr = wid >> 2, wc = wid & 3, fr = lane & 15, fq = lane >> 4;
    const int K = g.K, nt = K / BK;
    unsigned voffA[2], voffB[2];
#pragma unroll
    for (int i = 0; i < 2; ++i) { int R, C; stage_rc(tid * 16 + i * 8192, R, C); const int Rb = (R & ~31) + perm32(R & 31);
        const int Ra = Epi::ROWPERM ? (126 * (R >> 6) + 8 * (R & 15) + ((R >> 4) & 3)) : R;
        voffA[i] = (unsigned)(Ra * K + C) * 2u; voffB[i] = (unsigned)(Rb * K + C) * 2u; }
    const size_t kstep = (size_t)(BK * 2);
    const size_t hstepA = g.a_hstep, hstepB = g.b_hstep;
    const unsigned ldsw = (unsigned)wid * 1024u;
    const int aoff = lds_byte(wr * 64 + fr, fq * 8), boff = lds_byte(wc * 32 + fr, fq * 8);
#define PG8_SA(b, h) (((b) * 2 + (h)) * HTB)
#define PG8_SB(b, h) ((4 + (b) * 2 + (h)) * HTB)
#define PG8_STAGE(bufoff, gbase, voff) do { _Pragma("unroll") for (int _i = 0; _i < 2; ++_i) \
        __builtin_amdgcn_global_load_lds((const unsigned*)((const char*)(gbase) + (voff)[_i]), (LAS unsigned*)(lds + (bufoff) + ldsw + _i * 8192), 16, 0, 0); } while (0)
#define PG8_LDA(dst, b, h) do { _Pragma("unroll") for (int m = 0; m < 4; ++m) _Pragma("unroll") for (int k = 0; k < 2; ++k) dst[m][k] = *(const LAS bf16x8*)(lds + PG8_SA(b, h) + aoff + m * 2048 + k * 1024); } while (0)
#define PG8_LDB(dst, b, h) do { _Pragma("unroll") for (int n = 0; n < 2; ++n) _Pragma("unroll") for (int k = 0; k < 2; ++k) dst[n][k] = *(const LAS bf16x8*)(lds + PG8_SB(b, h) + boff + n * 2048 + k * 1024); } while (0)
#define PG8_MMA(ai, bj, At, Bt) do { __builtin_amdgcn_s_setprio(1); _Pragma("unroll") for (int m = 0; m < 4; ++m) _Pragma("unroll") for (int n = 0; n < 2; ++n) _Pragma("unroll") for (int k = 0; k < 2; ++k) \
        acc[ai][bj][m][n] = __builtin_amdgcn_mfma_f32_16x16x32_bf16(Bt[n][k], At[m][k], acc[ai][bj][m][n], 0, 0, 0); __builtin_amdgcn_s_setprio(0); } while (0)
#define PG8_WAIT_V(n) asm volatile("s_waitcnt vmcnt(" #n ")" ::: "memory")
#define PG8_WAIT_L(n) asm volatile("s_waitcnt lgkmcnt(" #n ")" ::: "memory")
#define PG8_BAR __builtin_amdgcn_s_barrier()
#define PG8_SCHED __builtin_amdgcn_sched_barrier(0)
    Unit cur, nxt; int ui = 0;
    if (!S.next(0, cur)) return;
    f32x4 acc[2][2][4][2];
#pragma unroll
    for (int a = 0; a < 2; ++a)
#pragma unroll
        for (int b = 0; b < 2; ++b)
#pragma unroll
            for (int m = 0; m < 4; ++m)
#pragma unroll
                for (int n = 0; n < 2; ++n) acc[a][b][m][n] = (f32x4){0.f, 0.f, 0.f, 0.f};
    bf16x8 At[4][2], B0[2][2], B1[2][2];
    const char* cA = (const char*)g.A + (size_t)cur.pm * g.a_tstep; const char* cB = (const char*)g.Bt + (size_t)cur.pn * g.b_tstep;
    PG8_STAGE(PG8_SB(0, 0), cB, voffB); PG8_STAGE(PG8_SB(0, 1), cB + hstepB, voffB); PG8_STAGE(PG8_SA(0, 0), cA, voffA); PG8_STAGE(PG8_SA(0, 1), cA + hstepA, voffA);
    if (wr == 1) PG8_BAR;
    PG8_WAIT_V(2); PG8_BAR;
    PG8_STAGE(PG8_SB(1, 0), cB + kstep, voffB); PG8_STAGE(PG8_SA(1, 0), cA + kstep, voffA); PG8_STAGE(PG8_SB(1, 1), cB + hstepB + kstep, voffB);
    PG8_WAIT_V(6); PG8_BAR;
    for (;;) {
        const bool has_next = S.next(ui + 1, nxt);
        const char* nA = has_next ? (const char*)g.A + (size_t)nxt.pm * g.a_tstep : cA; const char* nB = has_next ? (const char*)g.Bt + (size_t)nxt.pn * g.b_tstep : cB;
        for (int t = 0; t < nt; t += 2) {
            const bool last = (t == nt - 2);
            const char* a1 = cA + (size_t)(t + 1) * kstep;
            const char* a2 = last ? nA : cA + (size_t)(t + 2) * kstep; const char* b2 = last ? nB : cB + (size_t)(t + 2) * kstep;
            const char* a3 = a2 + kstep; const char* b3 = b2 + kstep;
            if constexpr (Epi::HOOK) { if (t == 4 || t == 12) E.hook(acc, cur, t, wr, wc, fr, fq); }
            PG8_LDB(B0, 0, 0); PG8_LDB(B1, 0, 1); PG8_SCHED; PG8_LDA(At, 0, 0); PG8_STAGE(PG8_SA(1, 1), a1 + hstepA, voffA);
            PG8_WAIT_V(8); PG8_WAIT_L(0); PG8_BAR; PG8_MMA(0, 0, At, B0); PG8_MMA(0, 1, At, B1); PG8_BAR; PG8_SCHED;
            PG8_LDA(At, 0, 1); PG8_STAGE(PG8_SB(0, 0), b2, voffB); PG8_STAGE(PG8_SB(0, 1), b2 + hstepB, voffB); PG8_STAGE(PG8_SA(0, 0), a2, voffA);
            PG8_WAIT_V(8); PG8_WAIT_L(0); PG8_BAR; PG8_MMA(1, 0, At, B0); PG8_MMA(1, 1, At, B1); PG8_BAR; PG8_SCHED;
            PG8_LDB(B0, 1, 0); PG8_LDB(B1, 1, 1); PG8_SCHED; PG8_LDA(At, 1, 0); PG8_STAGE(PG8_SA(0, 1), a2 + hstepA, voffA);
            PG8_WAIT_V(8); PG8_WAIT_L(0); PG8_BAR; PG8_MMA(0, 0, At, B0); PG8_MMA(0, 1, At, B1); PG8_BAR; PG8_SCHED;
            PG8_LDA(At, 1, 1); PG8_STAGE(PG8_SB(1, 0), b3, voffB); PG8_STAGE(PG8_SB(1, 1), b3 + hstepB, voffB); PG8_STAGE(PG8_SA(1, 0), a3, voffA);
            PG8_WAIT_V(8); PG8_WAIT_L(0); PG8_BAR; PG8_MMA(1, 0, At, B0); PG8_MMA(1, 1, At, B1); PG8_BAR; PG8_SCHED;
        }
        if (wr == 0) PG8_BAR;
        E(acc, cur, wr, wc, fr, fq);
        if (!has_next) break;
#pragma unroll
        for (int a = 0; a < 2; ++a)
#pragma unroll
            for (int b = 0; b < 2; ++b)
#pragma unroll
                for (int m = 0; m < 4; ++m)
#pragma unroll
                    for (int n = 0; n < 2; ++n) acc[a][b][m][n] = (f32x4){0.f, 0.f, 0.f, 0.f};
        cur = nxt; cA = nA; cB = nB; ++ui;
        if (wr == 1) PG8_BAR;
    }
    PG8_WAIT_V(0);
    PG8_BAR;
#undef PG8_SA
#undef PG8_SB
#undef PG8_STAGE
#undef PG8_LDA
#undef PG8_LDB
#undef PG8_MMA
#undef PG8_WAIT_V
#undef PG8_WAIT_L
#undef PG8_BAR
#undef PG8_SCHED
}
}
using pg8::Unit;
typedef f32x4 Acc[2][2][4][2];

DI u32x4 pack8(f32x4 a, f32x4 b) { u32x4 w; w.x = pk2(a[0], a[1]); w.y = pk2(a[2], a[3]); w.z = pk2(b[0], b[1]); w.w = pk2(b[2], b[3]); return w; }
DI float sigmoidf_(float x) { return __builtin_amdgcn_rcpf(1.f + __builtin_amdgcn_exp2f(-x * LOG2E)); }

struct EpiIn {
    static constexpr bool HOOK = false, ROWPERM = false;
    bf16_t* QKU; bf16_t* GATES; const float* b_gate;
    DI void operator()(const Acc& acc, const Unit& u, int wr, int wc, int fr, int fq) const {
        const int row0 = u.pm * 256 + wr * 64 + fr, pn = u.pn;
        const bool isg = pn >= 6;
        const float sc = (pn == 1 || pn == 2 || pn == 5) ? QSCALE : 1.f;
        bf16_t* base = isg ? GATES : QKU; const int ldc = isg ? GATE_P : QKU_P;
        const int col0 = (isg ? (pn - 6) : pn) * 256 + wc * 32 + 8 * fq;
        f32x4 bv[2][2];
#pragma unroll
        for (int bj = 0; bj < 2; ++bj)
#pragma unroll
            for (int n = 0; n < 2; ++n) bv[bj][n] = isg ? *(const f32x4*)(b_gate + col0 + bj * 128 + 4 * n) : (f32x4){0.f, 0.f, 0.f, 0.f};
#pragma unroll
        for (int ai = 0; ai < 2; ++ai)
#pragma unroll
            for (int m = 0; m < 4; ++m) { bf16_t* rowp = base + (size_t)(row0 + ai * 128 + m * 16) * ldc + col0;
#pragma unroll
                for (int bj = 0; bj < 2; ++bj) { f32x4 v0 = acc[ai][bj][m][0], v1 = acc[ai][bj][m][1];
                    if (isg) {
                        v0 = v0 + bv[bj][0]; v1 = v1 + bv[bj][1];
#pragma unroll
                        for (int j = 0; j < 4; ++j) { v0[j] = fmaxf(sigmoidf_(v0[j]), 1e-9f); v1[j] = fmaxf(sigmoidf_(v1[j]), 1e-9f); }
                    } else { v0 = v0 * sc; v1 = v1 * sc; }
                    *(u32x4*)(rowp + bj * 128) = pack8(v0, v1); } }
    }
};
struct EpiVT {
    static constexpr bool HOOK = false, ROWPERM = false;
    bf16_t* VT;
    DI void operator()(const Acc& acc, const Unit& u, int wr, int wc, int fr, int fq) const {
        const int row0 = u.pm * 256 + wr * 64 + fr, col0 = u.pn * 256 + wc * 32 + 8 * fq;
#pragma unroll
        for (int ai = 0; ai < 2; ++ai)
#pragma unroll
            for (int m = 0; m < 4; ++m) { bf16_t* rowp = VT + (size_t)(row0 + ai * 128 + m * 16) * S + col0;
#pragma unroll
                for (int bj = 0; bj < 2; ++bj) *(u32x4*)(rowp + bj * 128) = pack8(acc[ai][bj][m][0], acc[ai][bj][m][1]); }
    }
};
struct EpiMerge {
    static constexpr bool HOOK = true, ROWPERM = false;
    const bf16_t* GATES; bf16_t* MERGED;
    DI void hook(Acc& acc, const Unit& u, int t, int wr, int wc, int fr, int fq) const {
        int row0 = u.pm * 256 + wr * 64 + fr; const int col0 = u.pn * 256 + wc * 32 + 8 * fq;
        asm volatile("" : "+v"(row0));
        const int ga = (t == 4) ? 0 : D, gb = ga + D;
#pragma unroll
        for (int ai = 0; ai < 2; ++ai)
#pragma unroll
            for (int m = 0; m < 4; ++m) { const bf16_t* gp = GATES + (size_t)(row0 + ai * 128 + m * 16) * GATE_P + col0;
#pragma unroll
                for (int bj = 0; bj < 2; ++bj) { const u32x4 a = *(const u32x4*)(gp + ga + bj * 128), b = *(const u32x4*)(gp + gb + bj * 128);
                    f32x4 r0, r1;
                    r0[0] = bflo(a.x) * __builtin_amdgcn_rcpf(bflo(b.x)); r0[1] = bfhi(a.x) * __builtin_amdgcn_rcpf(bfhi(b.x));
                    r0[2] = bflo(a.y) * __builtin_amdgcn_rcpf(bflo(b.y)); r0[3] = bfhi(a.y) * __builtin_amdgcn_rcpf(bfhi(b.y));
                    r1[0] = bflo(a.z) * __builtin_amdgcn_rcpf(bflo(b.z)); r1[1] = bfhi(a.z) * __builtin_amdgcn_rcpf(bfhi(b.z));
                    r1[2] = bflo(a.w) * __builtin_amdgcn_rcpf(bflo(b.w)); r1[3] = bfhi(a.w) * __builtin_amdgcn_rcpf(bfhi(b.w));
                    acc[ai][bj][m][0] = acc[ai][bj][m][0] * r0; acc[ai][bj][m][1] = acc[ai][bj][m][1] * r1; } }
    }
    DI void operator()(const Acc& acc, const Unit& u, int wr, int wc, int fr, int fq) const {
        const int row0 = u.pm * 256 + wr * 64 + fr, col0 = u.pn * 256 + wc * 32 + 8 * fq;
#pragma unroll
        for (int ai = 0; ai < 2; ++ai)
#pragma unroll
            for (int m = 0; m < 4; ++m) { const size_t row = (size_t)(row0 + ai * 128 + m * 16);
#pragma unroll
                for (int bj = 0; bj < 2; ++bj) { const u32x4 a = *(const u32x4*)(GATES + row * GATE_P + 2 * D + col0 + bj * 128);
                    const f32x4 g0 = {bflo(a.x), bfhi(a.x), bflo(a.y), bfhi(a.y)}, g1 = {bflo(a.z), bfhi(a.z), bflo(a.w), bfhi(a.w)};
                    *(u32x4*)(MERGED + row * D + col0 + bj * 128) = pack8(acc[ai][bj][m][0] * g0, acc[ai][bj][m][1] * g1); } }
    }
};
template <bool WRITE_BF16>
struct EpiResid {
    static constexpr bool HOOK = false, ROWPERM = false;
    const float* XI; float* XO; bf16_t* XB; float* PART;
    DI void operator()(const Acc& acc, const Unit& u, int wr, int wc, int fr, int fq) const {
        const int row0 = u.pm * 256 + wr * 64 + fr, col0 = u.pn * 256 + wc * 32 + 8 * fq;
#pragma unroll
        for (int ai = 0; ai < 2; ++ai)
#pragma unroll
            for (int m = 0; m < 4; ++m) { const size_t row = (size_t)(row0 + ai * 128 + m * 16); float ss = 0.f;
#pragma unroll
                for (int bj = 0; bj < 2; ++bj) { const size_t off = row * D + col0 + bj * 128;
                    const f32x4 v0 = *(const f32x4*)(XI + off) + acc[ai][bj][m][0], v1 = *(const f32x4*)(XI + off + 4) + acc[ai][bj][m][1];
                    *(f32x4*)(XO + off) = v0; *(f32x4*)(XO + off + 4) = v1;
                    if (WRITE_BF16) *(u32x4*)(XB + off) = pack8(v0, v1);
                    ss += (v0[0] * v0[0] + v0[1] * v0[1]) + (v0[2] * v0[2] + v0[3] * v0[3]) + (v1[0] * v1[0] + v1[1] * v1[1]) + (v1[2] * v1[2] + v1[3] * v1[3]); }
                ss += __shfl_xor(ss, 16); ss += __shfl_xor(ss, 32);
                if (fq == 0) PART[row * 16 + u.pn * 4 + wc] = ss; }
    }
};
struct EpiFfnUp {
    static constexpr bool HOOK = false, ROWPERM = true;
    bf16_t* ACT; const float* PART; const float* conv_w; const float* conv_b;
    DI void operator()(const Acc& acc, const Unit& u, int wr, int wc, int fr, int fq) const {
        const int r0 = 252 * u.pm - 2 + 126 * wr + 8 * fr;
        float rs[8];
#pragma unroll
        for (int i = 0; i < 8; ++i) { const int row = r0 + i; float v = 0.f;
            if (row >= 0 && row < S) { const f32x4* p = (const f32x4*)(PART + (size_t)row * 16); const f32x4 a = p[0], b = p[1], c = p[2], d = p[3];
                const f32x4 t = (a + b) + (c + d); v = __builtin_amdgcn_rsqf(((t[0] + t[1]) + (t[2] + t[3])) * (1.f / D) + EPS); }
            rs[i] = v; }
        const int j0 = 128 * u.pn + 32 * wc + 8 * fq;
#pragma unroll
        for (int n = 0; n < 2; ++n) {
            const int jc = j0 + 4 * n;
            const f32x4 wg0 = *(const f32x4*)(conv_w + jc), wg1 = *(const f32x4*)(conv_w + 2 * DFF + jc), wg2 = *(const f32x4*)(conv_w + 4 * DFF + jc), bg = *(const f32x4*)(conv_b + jc);
            const f32x4 wv0 = *(const f32x4*)(conv_w + DFF + jc), wv1 = *(const f32x4*)(conv_w + 3 * DFF + jc), wv2 = *(const f32x4*)(conv_w + 5 * DFF + jc), bv = *(const f32x4*)(conv_b + DFF + jc);
            f32x4 g[8], v[8];
#pragma unroll
            for (int i = 0; i < 8; ++i) { g[i] = acc[i >> 2][0][i & 3][n] * rs[i]; v[i] = acc[i >> 2][1][i & 3][n] * rs[i]; }
            f32x4 gp6, gp7, vp6, vp7;
#pragma unroll
            for (int j = 0; j < 4; ++j) {
                gp6[j] = dpp_shr1(g[6][j]);
                gp7[j] = dpp_shr1(g[7][j]);
                vp6[j] = dpp_shr1(v[6][j]);
                vp7[j] = dpp_shr1(v[7][j]); }
#pragma unroll
            for (int i = 7; i >= 0; --i) {
                const f32x4 gm1 = (i >= 1) ? g[i - 1] : gp7, gm2 = (i >= 2) ? g[i - 2] : (i == 1 ? gp7 : gp6);
                const f32x4 vm1 = (i >= 1) ? v[i - 1] : vp7, vm2 = (i >= 2) ? v[i - 2] : (i == 1 ? vp7 : vp6);
                const f32x4 cg = bg + wg2 * g[i] + wg1 * gm1 + wg0 * gm2;
                const f32x4 cv = bv + wv2 * v[i] + wv1 * vm1 + wv0 * vm2;
                const f32x2 ga = gelu_pk((f32x2){cg[0], cg[1]}), gb = gelu_pk((f32x2){cg[2], cg[3]});
                const int row = r0 + i;
                if ((8 * fr + i >= 2) && row < S) { u32x2 w; w.x = pk2(ga.x * cv[0], ga.y * cv[1]); w.y = pk2(gb.x * cv[2], gb.y * cv[3]);
                    *(u32x2*)(ACT + (size_t)row * DFF + jc) = w; }
            }
        }
    }
};

#define MFMA32(a, b, c) __builtin_amdgcn_mfma_f32_32x32x16_bf16((a), (b), (c), 0, 0, 0)
DI int crow(int i, int g) { return (i & 3) + 8 * (i >> 2) + 4 * g; }
DI void attn_wave(const bf16_t* Q, int qp, const bf16_t* Kb, int kp, const bf16_t* VT, int vtp, int nsteps, int jt0,
                  const LAS float* bias, bool has_bias, bf16_t* O, int op, int lane) {
    const int r = lane & 31, g = lane >> 5;
    bf16x8 qf[2][4];
#pragma unroll
    for (int qb = 0; qb < 2; ++qb)
#pragma unroll
        for (int st = 0; st < 4; ++st) qf[qb][st] = *(const bf16x8*)(Q + (size_t)(32 * qb + r) * qp + 16 * st + 8 * g);
    f32x16 o[2][2]; float mrun[2] = {-1e30f, -1e30f}, lrun[2] = {0.f, 0.f};
#pragma unroll
    for (int a = 0; a < 2; ++a)
#pragma unroll
        for (int b = 0; b < 2; ++b)
#pragma unroll
            for (int i = 0; i < 16; ++i) o[a][b][i] = 0.f;
    const bf16_t* kptr = Kb + (size_t)r * kp + 8 * g;
    const bf16_t* vptr0 = VT + (size_t)r * vtp + 4 * g;
    const bf16_t* vptr1 = vptr0 + (size_t)32 * vtp;
    const size_t kstep = (size_t)32 * kp;
    for (int it = 0; it < nsteps; ++it) {
        f32x16 s[2];
#pragma unroll
        for (int b = 0; b < 2; ++b)
#pragma unroll
            for (int i = 0; i < 16; ++i) s[b][i] = 0.f;
        bf16x8 kf[4];
#pragma unroll
        for (int st = 0; st < 4; ++st) kf[st] = *(const bf16x8*)(kptr + 16 * st);
        s16x4 v0[4], v1[4];
#pragma unroll
        for (int j = 0; j < 4; ++j) { v0[j] = *(const s16x4*)(vptr0 + 8 * j); v1[j] = *(const s16x4*)(vptr1 + 8 * j); }
        kptr += kstep; vptr0 += 32; vptr1 += 32;
#pragma unroll
        for (int st = 0; st < 4; ++st)
#pragma unroll
            for (int qb = 0; qb < 2; ++qb) s[qb] = MFMA32(kf[st], qf[qb][st], s[qb]);
        if (has_bias) { const int jt = jt0 + (it >> 1);
            if (jt <= 5) { const float c = bias[256];
#pragma unroll
                for (int qb = 0; qb < 2; ++qb)
#pragma unroll
                    for (int i = 0; i < 16; ++i) s[qb][i] += c;
            } else { const int base = 64 * (8 - jt) + 128 - 32 * (it & 1) + r - 4 * g;
#pragma unroll
                for (int qb = 0; qb < 2; ++qb)
#pragma unroll
                    for (int i = 0; i < 16; ++i) { const int idx = base + 32 * qb - ((i & 3) + 8 * (i >> 2)); s[qb][i] += bias[idx > 256 ? 256 : idx]; }
            } }
#pragma unroll
        for (int qb = 0; qb < 2; ++qb) {
            float mx = s[qb][0];
#pragma unroll
            for (int i = 1; i < 16; ++i) mx = fmaxf(mx, s[qb][i]);
            mx = fmaxf(mx, __shfl_xor(mx, 32));
            const float mn = fmaxf(mrun[qb], mx), al = __builtin_amdgcn_exp2f(mrun[qb] - mn); mrun[qb] = mn;
            float ls = 0.f;
#pragma unroll
            for (int i = 0; i < 16; ++i) { const float p = __builtin_amdgcn_exp2f(s[qb][i] - mn); s[qb][i] = p; ls += p; }
            lrun[qb] = lrun[qb] * al + ls;
#pragma unroll
            for (int db = 0; db < 2; ++db)
#pragma unroll
                for (int i = 0; i < 16; ++i) o[db][qb][i] *= al;
        }
#pragma unroll
        for (int sp = 0; sp < 2; ++sp) {
            bf16x8 pf[2];
#pragma unroll
            for (int qb = 0; qb < 2; ++qb) { u32x4 w; w.x = pk2(s[qb][8 * sp + 0], s[qb][8 * sp + 1]); w.y = pk2(s[qb][8 * sp + 2], s[qb][8 * sp + 3]);
                w.z = pk2(s[qb][8 * sp + 4], s[qb][8 * sp + 5]); w.w = pk2(s[qb][8 * sp + 6], s[qb][8 * sp + 7]); pf[qb] = __builtin_bit_cast(bf16x8, w); }
            const bf16x8 vf0 = __builtin_shufflevector(v0[2 * sp], v0[2 * sp + 1], 0, 1, 2, 3, 4, 5, 6, 7);
            const bf16x8 vf1 = __builtin_shufflevector(v1[2 * sp], v1[2 * sp + 1], 0, 1, 2, 3, 4, 5, 6, 7);
#pragma unroll
            for (int qb = 0; qb < 2; ++qb) { o[0][qb] = MFMA32(vf0, pf[qb], o[0][qb]); o[1][qb] = MFMA32(vf1, pf[qb], o[1][qb]); }
        }
    }
#pragma unroll
    for (int qb = 0; qb < 2; ++qb) { const float inv = 1.f / (lrun[qb] + __shfl_xor(lrun[qb], 32));
#pragma unroll
        for (int db = 0; db < 2; ++db)
#pragma unroll
            for (int ig = 0; ig < 4; ++ig) { u32x2 w; w.x = pk2(o[db][qb][4 * ig] * inv, o[db][qb][4 * ig + 1] * inv); w.y = pk2(o[db][qb][4 * ig + 2] * inv, o[db][qb][4 * ig + 3] * inv);
                *(u32x2*)(O + (size_t)(32 * qb + r) * op + 32 * db + 8 * ig + 4 * g) = w; } }
}

DI void transpose_item(const float* W, int N, bf16_t* WT, int ldt, int koff, int row_off, const float* kscale, LAS float* scr, int kb, int nb, int lane) {
    const int k0 = 64 * kb, n0 = 32 * nb;
#pragma unroll 8
    for (int i = 0; i < 32; ++i) { const int kk = 2 * i + (lane >> 5); float v = W[(size_t)(k0 + kk) * N + n0 + (lane & 31)]; if (kscale) v *= kscale[k0 + kk]; scr[kk * 33 + (lane & 31)] = v; }
    asm volatile("s_waitcnt lgkmcnt(0)" ::: "memory");
    const int c = lane & 7;
#pragma unroll
    for (int j = 0; j < 4; ++j) { const int n = (lane >> 3) + 8 * j; const LAS float* s = scr + (8 * c) * 33 + n;
        u32x4 o; o.x = pk2(s[0 * 33], s[1 * 33]); o.y = pk2(s[2 * 33], s[3 * 33]); o.z = pk2(s[4 * 33], s[5 * 33]); o.w = pk2(s[6 * 33], s[7 * 33]);
        *(u32x4*)(WT + (size_t)(row_off + n0 + n) * ldt + koff + k0 + 8 * c) = o; }
    asm volatile("s_waitcnt lgkmcnt(0)" ::: "memory");
}

DI void grid_bar(unsigned* ctr, unsigned target, int wave) {
    __syncthreads();
    if (wave == 0) { if (lane_id_v() == 0) {
        __atomic_thread_fence(__ATOMIC_SEQ_CST);
        __hip_atomic_fetch_add(ctr, 1u, __ATOMIC_RELEASE, __HIP_MEMORY_SCOPE_AGENT);
        while (__hip_atomic_load(ctr, __ATOMIC_ACQUIRE, __HIP_MEMORY_SCOPE_AGENT) < target) __builtin_amdgcn_s_sleep(2);
        __atomic_thread_fence(__ATOMIC_SEQ_CST);
    } }
    __syncthreads();
}


#ifdef DIAG
DI float bfv(const bf16_t* p) { return __builtin_bit_cast(float, (unsigned)(*p) << 16); }
DI float dotbb(const bf16_t* a, const bf16_t* b, int n) { float s = 0.f; for (int k = 0; k < n; ++k) s += bfv(a + k) * bfv(b + k); return s; }
DI unsigned hsh(unsigned x) { x ^= x >> 16; x *= 0x7feb352du; x ^= x >> 15; x *= 0x846ca68bu; x ^= x >> 16; return x; }
DI int srow(int tid) { return tid < 64 ? ((tid & 7) + 126 * (tid >> 3)) : (tid < 80 ? S - 1 - (tid - 64) : (int)(hsh(tid) % S)); }
DI void chk(unsigned* dg, int code, float got, float exp, float rel, float abs_) { if (!(fabsf(got - exp) <= rel * fabsf(exp) + abs_)) atomicMin(dg, (unsigned)code); }
#define DCHK(code, got, exp, rel, abs_) chk(dg, code, got, exp, rel, abs_)
#endif

struct Args { const float* in[20]; float* out; unsigned char* ws; int ph_lo, ph_hi; };

__global__ void __launch_bounds__(NWAVES * 64, 2) fwd_kernel(Args args) {
    extern __shared__ __attribute__((aligned(16))) unsigned char lds_raw[];
    LAS unsigned char* lds = (LAS unsigned char*)lds_raw;
    cg::grid_group grid = cg::this_grid();
    const int wave = __builtin_amdgcn_readfirstlane((int)threadIdx.x >> 6);
    const int G = gridDim.x, bx = blockIdx.x;
    const int vcu = (G % 8 == 0) ? (bx % 8) * (G / 8) + bx / 8 : bx;
    unsigned char* ws = args.ws;
    const float* x = args.in[0]; const float* mem = args.in[1]; const float* g_mix = args.in[2]; const float* g_mem = args.in[3];
    const float* w_in = args.in[4]; const float* b_gate = args.in[5]; const float* w_pool = args.in[6]; const float* pool_scale = args.in[7];
    const float* rel_bias = args.in[8]; const float* w_mem_kv = args.in[9]; const float* w_up_pool = args.in[10]; const float* w_up_attn = args.in[11];
    const float* w_up_mem = args.in[12]; const float* w_out = args.in[13]; const float* g_ffn = args.in[14]; const float* w_ffn_up = args.in[15];
    const float* conv_w = args.in[16]; const float* conv_b = args.in[17]; const float* w_ffn_down = args.in[18]; const float* g_final = args.in[19];
    float* out = args.out;
    bf16_t* WIN = (bf16_t*)(ws + WS_WIN); bf16_t* WUP = (bf16_t*)(ws + WS_WUP); bf16_t* WOUT = (bf16_t*)(ws + WS_WOUT); bf16_t* WFUP = (bf16_t*)(ws + WS_WFUP); bf16_t* WDN = (bf16_t*)(ws + WS_WDN);
    bf16_t* KM = (bf16_t*)(ws + WS_KM); bf16_t* VMT = (bf16_t*)(ws + WS_VMT); float* PART = (float*)(ws + WS_PART); float* PART2 = (float*)(ws + WS_PART2);
    bf16_t* R1 = (bf16_t*)(ws + WS_R1); bf16_t* QKU = (bf16_t*)(ws + WS_QKU); bf16_t* GATES = (bf16_t*)(ws + WS_GATES); bf16_t* VTb = (bf16_t*)(ws + WS_VT);
    bf16_t* MERGED = (bf16_t*)(ws + WS_MERGED); bf16_t* ACT = (bf16_t*)(ws + WS_ACT);
    const int lo = args.ph_lo, hi = args.ph_hi;
#define IN(k) (lo <= (k) && (k) < hi)
    unsigned* barw = (unsigned*)(ws + WS_BAR);
    unsigned nbar = 0;
#define GBAR() grid_bar(barw, (++nbar) * (unsigned)G, wave)
#define SEAM(k) do { if (IN(k) && IN((k) + 1)) { if ((k) == 0) grid.sync(); else GBAR(); } } while (0)

    if (IN(0)) {
        const int lane = lane_id_v(), tid = wave * 64 + lane;
        LAS float* scr = (LAS float*)(lds + wave * 16384);
        const int gw = wave * G + vcu, NGW = G * NWAVES;
        if (bx == 0) { for (int i = tid; i < 1024; i += 512) ((unsigned*)(ws + WS_R1 - 4096))[i] = 0u; if (tid == 0) { __hip_atomic_store(barw, 0u, __ATOMIC_RELAXED, __HIP_MEMORY_SCOPE_AGENT); __hip_atomic_store(barw + 64, 0x7fffffffu, __ATOMIC_RELAXED, __HIP_MEMORY_SCOPE_AGENT); } }
        constexpr int I_MKV = 128, I_WP = 512;
        constexpr int I_IN = 16 * 160, I_UA = 8 * 32, I_UM = 4 * 32, I_WO = 16 * 32, I_FU = 16 * 176, I_FD = 44 * 32;
        constexpr int I_ROWS = S;
        constexpr int NITEMS = I_MKV + I_WP + I_IN + I_UA + I_UM + I_WO + I_FU + I_FD + I_ROWS;
        for (int it = gw; it < NITEMS; it += NGW) {
            int r = it;
            if (r < I_MKV) {
                const int nb = r >> 3, mb = r & 7, rr = lane & 31, gg = lane >> 5; const int n0 = 32 * nb, m0 = 32 * mb;
                f32x16 acc; for (int i = 0; i < 16; ++i) acc[i] = 0.f;
                float ss = 0.f;
                const float* mrow = mem + (size_t)(m0 + rr) * D;
                for (int k0 = 0; k0 < D; k0 += 16) { const int kk = k0 + 8 * gg;
                    const f32x4 a0 = *(const f32x4*)(mrow + kk), a1 = *(const f32x4*)(mrow + kk + 4), g0 = *(const f32x4*)(g_mem + kk), g1 = *(const f32x4*)(g_mem + kk + 4);
                    ss += (a0[0] * a0[0] + a0[1] * a0[1]) + (a0[2] * a0[2] + a0[3] * a0[3]) + (a1[0] * a1[0] + a1[1] * a1[1]) + (a1[2] * a1[2] + a1[3] * a1[3]);
                    const bf16x8 bfr = __builtin_bit_cast(bf16x8, pack8(a0 * g0, a1 * g1));
                    float wv[8];
#pragma unroll
                    for (int j = 0; j < 8; ++j) wv[j] = w_mem_kv[(size_t)(kk + j) * 512 + n0 + rr];
                    u32x4 wa; wa.x = pk2(wv[0], wv[1]); wa.y = pk2(wv[2], wv[3]); wa.z = pk2(wv[4], wv[5]); wa.w = pk2(wv[6], wv[7]);
                    acc = MFMA32(__builtin_bit_cast(bf16x8, wa), bfr, acc); }
                ss += __shfl_xor(ss, 32);
                const float rstd = __builtin_amdgcn_rsqf(ss * (1.f / D) + EPS);
                const int mI = m0 + rr;
                if (n0 < 256) {
#pragma unroll
                    for (int ig = 0; ig < 4; ++ig) { u32x2 w; w.x = pk2(acc[4 * ig] * rstd, acc[4 * ig + 1] * rstd); w.y = pk2(acc[4 * ig + 2] * rstd, acc[4 * ig + 3] * rstd);
                        *(u32x2*)(KM + (size_t)mI * 256 + n0 + 8 * ig + 4 * gg) = w; }
                } else {
#pragma unroll
                    for (int i = 0; i < 16; ++i) VMT[(size_t)(n0 - 256 + crow(i, gg)) * 256 + mI] = (bf16_t)(pk2(acc[i] * rstd, 0.f) & 0xffffu);
                }
                continue; } r -= I_MKV;
            if (r < I_WP) {
                const int gI = r >> 7, c0 = ((r >> 4) & 7) * 8, n = (r & 15) * 64 + lane;
                float a[8]; for (int i = 0; i < 8; ++i) a[i] = 0.f;
                for (int d = 0; d < 64; ++d) { const float wv = w_up_pool[(size_t)(gI * 64 + d) * D + n] * pool_scale[gI * 64 + d];
#pragma unroll
                    for (int ci = 0; ci < 8; ++ci) a[ci] += w_pool[(size_t)((gI * 64 + c0 + ci) * 64) + d] * wv; }
                u32x4 w; w.x = pk2(a[0], a[1]); w.y = pk2(a[2], a[3]); w.z = pk2(a[4], a[5]); w.w = pk2(a[6], a[7]);
                *(u32x4*)(WUP + (size_t)n * D + gI * 64 + c0) = w;
                continue; } r -= I_WP;
            if (r < I_IN) { const int kb = r / 160, nb = r % 160, n0 = 32 * nb;
                const int ro = (n0 < 1280) ? 0 : (n0 < 1792) ? (4608 - 1280) : (n0 < 2048) ? (1280 - 1792) : -512;
                transpose_item(w_in, NIN, WIN, D, 0, ro, nullptr, scr, kb, nb, lane); continue; } r -= I_IN;
            if (r < I_UA) { transpose_item(w_up_attn, D, WUP, D, 256, 0, nullptr, scr, r / 32, r % 32, lane); continue; } r -= I_UA;
            if (r < I_UM) { transpose_item(w_up_mem, D, WUP, D, 768, 0, nullptr, scr, r / 32, r % 32, lane); continue; } r -= I_UM;
            if (r < I_WO) { transpose_item(w_out, D, WOUT, D, 0, 0, nullptr, scr, r / 32, r % 32, lane); continue; } r -= I_WO;
            if (r < I_FU) { transpose_item(w_ffn_up, 2 * DFF, WFUP, D, 0, 0, g_ffn, scr, r / 176, r % 176, lane); continue; } r -= I_FU;
            if (r < I_FD) { transpose_item(w_ffn_down, D, WDN, DFF, 0, 0, nullptr, scr, r / 32, r % 32, lane); continue; } r -= I_FD;
            {
                const f32x4* xr = (const f32x4*)(x + (size_t)r * D) + lane; const f32x4* gr = (const f32x4*)g_mix + lane;
                f32x4 v[4]; float s = 0.f;
#pragma unroll
                for (int j = 0; j < 4; ++j) { v[j] = xr[64 * j]; s += (v[j][0] * v[j][0] + v[j][1] * v[j][1]) + (v[j][2] * v[j][2] + v[j][3] * v[j][3]); }
                const float rstd = __builtin_amdgcn_rsqf(wave_sum(s) * (1.f / D) + EPS);
                u32x2* o8 = (u32x2*)(R1 + (size_t)r * D) + lane;
#pragma unroll
                for (int j = 0; j < 4; ++j) { const f32x4 gg = gr[64 * j]; u32x2 w; w.x = pk2(v[j][0] * rstd * gg[0], v[j][1] * rstd * gg[1]); w.y = pk2(v[j][2] * rstd * gg[2], v[j][3] * rstd * gg[3]); o8[64 * j] = w; }
            }
        }
    }
    SEAM(0);
#ifdef DIAG
    unsigned* dg = (unsigned*)(ws + WS_BAR + 256);
    if (bx == 0) { const int tid = wave * 64 + lane_id_v(); const unsigned h = hsh(tid * 7 + 1);
        { const int n = h % NIN, k = (h >> 13) % D; const int np = (n < 1280) ? n : (n < 1792) ? n + 3328 : n - 512; DCHK(11, bfv(WIN + (size_t)np * D + k), w_in[(size_t)k * NIN + n], 0.01f, 1e-4f); }
        { const int n = h % D, k = (h >> 13) % 512; DCHK(12, bfv(WUP + (size_t)n * D + 256 + k), w_up_attn[(size_t)k * D + n], 0.01f, 1e-4f); }
        { const int n = h % D, k = (h >> 13) % 256; DCHK(13, bfv(WUP + (size_t)n * D + 768 + k), w_up_mem[(size_t)k * D + n], 0.01f, 1e-4f); }
        { const int n = h % D, gc = (h >> 13) % 256, gI = gc >> 6; float e = 0.f; for (int d = 0; d < 64; ++d) e += w_pool[(size_t)gc * 64 + d] * pool_scale[gI * 64 + d] * w_up_pool[(size_t)(gI * 64 + d) * D + n];
          DCHK(14, bfv(WUP + (size_t)n * D + gc), e, 0.01f, 1e-3f); }
        { const int n = h % D, k = (h >> 13) % D; DCHK(15, bfv(WOUT + (size_t)n * D + k), w_out[(size_t)k * D + n], 0.01f, 1e-4f); }
        { const int n = h % (2 * DFF), k = (h >> 13) % D; DCHK(16, bfv(WFUP + (size_t)n * D + k), w_ffn_up[(size_t)k * 2 * DFF + n] * g_ffn[k], 0.01f, 1e-4f); }
        { const int n = h % D, k = (h >> 13) % DFF; DCHK(17, bfv(WDN + (size_t)n * DFF + k), w_ffn_down[(size_t)k * D + n], 0.01f, 1e-4f); }
        { const int m = h % 256, n = (h >> 13) % 512; float ss = 0.f, e = 0.f; for (int k = 0; k < D; ++k) { const float a = mem[(size_t)m * D + k]; ss += a * a; e += a * g_mem[k] * w_mem_kv[(size_t)k * 512 + n]; }
          e *= 1.f / sqrtf(ss / D + EPS); const float got = (n < 256) ? bfv(KM + (size_t)m * 256 + n) : bfv(VMT + (size_t)(n - 256) * 256 + m); DCHK(18, got, e, 0.02f, 5e-3f); }
        { const int r = srow(tid), c = (h >> 7) % D; float ss = 0.f; for (int k = 0; k < D; ++k) { const float a = x[(size_t)r * D + k]; ss += a * a; }
          DCHK(19, bfv(R1 + (size_t)r * D + c), x[(size_t)r * D + c] / sqrtf(ss / D + EPS) * g_mix[c], 0.01f, 1e-3f); }
        if (tid < 1024) DCHK(10, bfv(R1 - 2 * D + tid) + bfv(R1 - 2 * D + tid + 512) + bfv(R1 - 2 * D + tid + 1024) + bfv(R1 - 2 * D + tid + 1536), 0.f, 0.f, 0.f);
    }
    GBAR();
#endif
    if (IN(1)) {
        { pg8::Gemm g{R1, WIN, D, (size_t)256 * D * 2, (size_t)128 * D * 2, (size_t)256 * D * 2, (size_t)128 * D * 2};
          pg8::StaticOrder So; So.init(S / 256, 18, G, bx); EpiIn E{QKU, GATES, b_gate};
          pg8::gemm_phase<EpiIn, pg8::StaticOrder>(lds, g, So, E, wave); }
        { pg8::Gemm g{WIN + (size_t)4608 * D, R1, D, (size_t)256 * D * 2, (size_t)128 * D * 2, (size_t)256 * D * 2, (size_t)128 * D * 2};
          pg8::StaticOrder So; So.init(2, S / 256, G, (bx + G / 2) % G); EpiVT E{VTb};
          pg8::gemm_phase<EpiVT, pg8::StaticOrder>(lds, g, So, E, wave); }
    }
    SEAM(1);
#ifdef DIAG
    if (bx == 0) { const int tid = wave * 64 + lane_id_v(); const unsigned h = hsh(tid * 11 + 3); const int r = srow(tid);
        { const int c = h % 4608; float e = dotbb(R1 + (size_t)r * D, WIN + (size_t)c * D, D);
          if (c < 1536) { if ((c >= 256 && c < 768) || c >= 1280) e *= QSCALE; DCHK(21 + (c >= 256) + (c >= 768) + (c >= 1280), bfv(QKU + (size_t)r * QKU_P + c), e, 0.02f, 0.02f); }
          else { e = 1.f / (1.f + expf(-(e + b_gate[c - 1536]))); DCHK(25, bfv(GATES + (size_t)r * GATE_P + c - 1536), e, 0.02f, 0.01f); } }
        { const int c = h % 512; const float e = dotbb(R1 + (size_t)r * D, WIN + (size_t)(4608 + c) * D, D); DCHK(26, bfv(VTb + (size_t)c * S + r), e, 0.02f, 0.02f); }
    }
    GBAR();
#endif
    if (IN(2)) {
        const int lane = lane_id_v(), tid = wave * 64 + lane;
        LAS float* bl = (LAS float*)(lds + LDS_BIAS);
        for (int i = tid; i < 8 * 257; i += 512) bl[i] = rel_bias[i] * LOG2E;
        __syncthreads();
        bf16_t* OCAT = R1;
        for (int c = vcu; c < S / 64; c += G) {
            { const int jtmin = (c >= 8) ? 0 : 8 - c; const int tok0 = 64 * (c - 8 + jtmin);
              attn_wave(QKU + (size_t)64 * c * QKU_P + 256 + 64 * wave, QKU_P, QKU + (size_t)tok0 * QKU_P + 768 + 64 * wave, QKU_P,
                        VTb + (size_t)(64 * wave) * S + tok0, S, 2 * (9 - jtmin), jtmin, bl + wave * 257, true, OCAT + (size_t)64 * c * D + 256 + 64 * wave, D, lane); }
            if (wave < 4) {
                attn_wave(QKU + (size_t)64 * c * QKU_P + 1280 + 64 * wave, QKU_P, KM + 64 * wave, 256, VMT + (size_t)(64 * wave) * 256, 256, 8, 0,
                          bl, false, OCAT + (size_t)64 * c * D + 768 + 64 * wave, D, lane);
            } else {
                const int gI = wave - 4, win = 2 << gI, ch = gI * 64 + (lane & 7) * 8, t0 = 64 * c + (lane >> 3) * 8;
                const bf16_t* U = QKU + ch;
                float sm[8], cur[8];
#pragma unroll
                for (int j = 0; j < 8; ++j) { sm[j] = 0.f; cur[j] = 0.f; }
                for (int i = win - 1; i >= 0; --i) { const int t = t0 - i; if (t >= 0) { const u32x4 a = *(const u32x4*)(U + (size_t)t * QKU_P);
                        cur[0] = bflo(a.x); cur[1] = bfhi(a.x); cur[2] = bflo(a.y); cur[3] = bfhi(a.y); cur[4] = bflo(a.z); cur[5] = bfhi(a.z); cur[6] = bflo(a.w); cur[7] = bfhi(a.w);
#pragma unroll
                        for (int j = 0; j < 8; ++j) sm[j] += cur[j]; } }
                for (int k = 0; k < 8; ++k) { const int t = t0 + k;
                    if (k > 0) { const u32x4 a = *(const u32x4*)(U + (size_t)t * QKU_P);
                        cur[0] = bflo(a.x); cur[1] = bfhi(a.x); cur[2] = bflo(a.y); cur[3] = bfhi(a.y); cur[4] = bflo(a.z); cur[5] = bfhi(a.z); cur[6] = bflo(a.w); cur[7] = bfhi(a.w);
#pragma unroll
                        for (int j = 0; j < 8; ++j) sm[j] += cur[j];
                        const int tp = t - win;
                        if (tp >= 0) { const u32x4 b = *(const u32x4*)(U + (size_t)tp * QKU_P);
                            sm[0] -= bflo(b.x); sm[1] -= bfhi(b.x); sm[2] -= bflo(b.y); sm[3] -= bfhi(b.y); sm[4] -= bflo(b.z); sm[5] -= bfhi(b.z); sm[6] -= bflo(b.w); sm[7] -= bfhi(b.w); } }
                    const float ic = 1.f / (float)((t + 1 < win) ? t + 1 : win);
                    u32x4 w; w.x = pk2(sm[0] * ic - cur[0], sm[1] * ic - cur[1]); w.y = pk2(sm[2] * ic - cur[2], sm[3] * ic - cur[3]);
                    w.z = pk2(sm[4] * ic - cur[4], sm[5] * ic - cur[5]); w.w = pk2(sm[6] * ic - cur[6], sm[7] * ic - cur[7]);
                    *(u32x4*)(OCAT + (size_t)t * D + ch) = w; }
            }
        }
    }
    SEAM(2);
#ifdef DIAG
    if (bx == 0) { const int tid = wave * 64 + lane_id_v(); const unsigned h = hsh(tid * 13 + 5); const int t = srow(tid);
        { const int ch = h % 256, gI = ch >> 6, win = 2 << gI; float sm = 0.f; for (int i = 0; i < win; ++i) if (t - i >= 0) sm += bfv(QKU + (size_t)(t - i) * QKU_P + ch);
          const float e = sm / (float)((t + 1 < win) ? t + 1 : win) - bfv(QKU + (size_t)t * QKU_P + ch); DCHK(31, bfv(R1 + (size_t)t * D + ch), e, 0.02f, 0.02f); }
        { const int hh = (h >> 8) % 8, d = (h >> 12) % 64, c = t >> 6; float mx = -1e30f, den = 0.f, num = 0.f;
          for (int pass = 0; pass < 2; ++pass) for (int j = 0; j < 576; ++j) { const int kt = 64 * (c - 8) + j; if (kt < 0) continue;
              float sc = dotbb(QKU + (size_t)t * QKU_P + 256 + 64 * hh, QKU + (size_t)kt * QKU_P + 768 + 64 * hh, 64);
              int rel = t - kt; rel = rel > 128 ? 128 : (rel < -128 ? -128 : rel); sc += rel_bias[hh * 257 + rel + 128] * LOG2E;
              if (pass == 0) mx = fmaxf(mx, sc); else { const float p = exp2f(sc - mx); den += p; num += p * bfv(VTb + (size_t)(64 * hh + d) * S + kt); } }
          DCHK(32, bfv(R1 + (size_t)t * D + 256 + 64 * hh + d), num / den, 0.03f, 0.01f); }
        { const int hh = (h >> 8) % 4, d = (h >> 12) % 64; float mx = -1e30f, den = 0.f, num = 0.f;
          for (int pass = 0; pass < 2; ++pass) for (int j = 0; j < 256; ++j) { const float sc = dotbb(QKU + (size_t)t * QKU_P + 1280 + 64 * hh, KM + (size_t)j * 256 + 64 * hh, 64);
              if (pass == 0) mx = fmaxf(mx, sc); else { const float p = exp2f(sc - mx); den += p; num += p * bfv(VMT + (size_t)(64 * hh + d) * 256 + j); } }
          DCHK(33, bfv(R1 + (size_t)t * D + 768 + 64 * hh + d), num / den, 0.03f, 0.01f); }
    }
    GBAR();
#endif
    if (IN(3)) {
        pg8::Gemm g{R1, WUP, D, (size_t)256 * D * 2, (size_t)128 * D * 2, (size_t)256 * D * 2, (size_t)128 * D * 2};
        pg8::StaticOrder So; So.init(S / 256, 4, G, bx); EpiMerge E{GATES, MERGED};
        pg8::gemm_phase<EpiMerge, pg8::StaticOrder>(lds, g, So, E, wave);
    }
    SEAM(3);
#ifdef DIAG
    if (bx == 0) { const int tid = wave * 64 + lane_id_v(); const unsigned h = hsh(tid * 17 + 7); const int r = srow(tid), c = h % D;
        const float y0 = dotbb(R1 + (size_t)r * D, WUP + (size_t)c * D, 256), y1 = dotbb(R1 + (size_t)r * D + 256, WUP + (size_t)c * D + 256, 512), y2 = dotbb(R1 + (size_t)r * D + 768, WUP + (size_t)c * D + 768, 256);
        const float e = bfv(GATES + (size_t)r * GATE_P + c) * y0 + bfv(GATES + (size_t)r * GATE_P + D + c) * y1 + bfv(GATES + (size_t)r * GATE_P + 2 * D + c) * y2;
        DCHK(41, bfv(MERGED + (size_t)r * D + c), e, 0.03f, 0.02f); }
    GBAR();
#endif
    if (IN(4)) {
        pg8::Gemm g{MERGED, WOUT, D, (size_t)256 * D * 2, (size_t)128 * D * 2, (size_t)256 * D * 2, (size_t)128 * D * 2};
        pg8::StaticOrder So; So.init(S / 256, 4, G, bx); EpiResid<true> E{x, out, R1, PART};
        pg8::gemm_phase<EpiResid<true>, pg8::StaticOrder>(lds, g, So, E, wave);
    }
    SEAM(4);
#ifdef DIAG
    if (bx == 0) { const int tid = wave * 64 + lane_id_v(); const unsigned h = hsh(tid * 19 + 9); const int r = srow(tid), c = h % D;
        const float e = x[(size_t)r * D + c] + dotbb(MERGED + (size_t)r * D, WOUT + (size_t)c * D, D);
        DCHK(51, out[(size_t)r * D + c], e, 0.02f, 0.02f); DCHK(52, bfv(R1 + (size_t)r * D + c), e, 0.02f, 0.02f);
        float ss = 0.f, ps = 0.f; for (int k = 0; k < D; ++k) { const float a = out[(size_t)r * D + k]; ss += a * a; } for (int k = 0; k < 16; ++k) ps += PART[(size_t)r * 16 + k];
        DCHK(53, ps, ss, 0.001f, 0.f); }
    GBAR();
#endif
    if (IN(5)) {
        pg8::Gemm g{R1 - 2 * D, WFUP, D, (size_t)252 * D * 2, (size_t)4 * D * 2, (size_t)128 * D * 2, (size_t)DFF * D * 2};
        pg8::StaticOrder So; So.init(66, 22, G, bx); EpiFfnUp E{ACT, PART, conv_w, conv_b};
        pg8::gemm_phase<EpiFfnUp, pg8::StaticOrder>(lds, g, So, E, wave);
    }
    SEAM(5);
#ifdef DIAG
    if (bx == 0) { const int tid = wave * 64 + lane_id_v(); const unsigned h = hsh(tid * 23 + 11); const int t = srow(tid), j = h % DFF;
        float cg = conv_b[j], cv = conv_b[DFF + j];
        for (int k = 0; k < 3; ++k) { const int tt = t - 2 + k; if (tt < 0) continue; float ps = 0.f; for (int q = 0; q < 16; ++q) ps += PART[(size_t)tt * 16 + q];
            const float rstd = 1.f / sqrtf(ps / D + EPS);
            cg += conv_w[(size_t)k * 2 * DFF + j] * rstd * dotbb(R1 + (size_t)tt * D, WFUP + (size_t)j * D, D);
            cv += conv_w[(size_t)k * 2 * DFF + DFF + j] * rstd * dotbb(R1 + (size_t)tt * D, WFUP + (size_t)(DFF + j) * D, D); }
        const float e = 0.5f * cg * (1.f + erff(cg * 0.70710678f)) * cv;
        DCHK(61 + ((tid < 64) ? (tid & 7) : 8), bfv(ACT + (size_t)t * DFF + j), e, 0.03f, 0.03f); }
    GBAR();
#endif
    if (IN(6)) {
        pg8::Gemm g{ACT, WDN, DFF, (size_t)256 * DFF * 2, (size_t)128 * DFF * 2, (size_t)256 * DFF * 2, (size_t)128 * DFF * 2};
        pg8::StaticOrder So; So.init(S / 256, 4, G, bx); EpiResid<false> E{out, out, nullptr, PART2};
        pg8::gemm_phase<EpiResid<false>, pg8::StaticOrder>(lds, g, So, E, wave);
    }
    SEAM(6);
#ifdef DIAG
    if (bx == 0) { const int tid = wave * 64 + lane_id_v(); const unsigned h = hsh(tid * 29 + 13); const int r = srow(tid), c = h % D;
        const float e = bfv(R1 + (size_t)r * D + c) + dotbb(ACT + (size_t)r * DFF, WDN + (size_t)c * DFF, DFF);
        DCHK(71, out[(size_t)r * D + c], e, 0.02f, 0.03f);
        float ss = 0.f, ps = 0.f; for (int k = 0; k < D; ++k) { const float a = out[(size_t)r * D + k]; ss += a * a; } for (int k = 0; k < 16; ++k) ps += PART2[(size_t)r * 16 + k];
        DCHK(72, ps, ss, 0.001f, 0.f); }
    GBAR();
#endif
    if (IN(7)) {
        const int lane = lane_id_v();
        const int gw = vcu * NWAVES + wave, NGW = G * NWAVES;
        for (int r = gw; r < S; r += NGW) {
            const f32x4* p = (const f32x4*)(PART2 + (size_t)r * 16); const f32x4 t = (p[0] + p[1]) + (p[2] + p[3]);
            const float rstd = __builtin_amdgcn_rsqf(((t[0] + t[1]) + (t[2] + t[3])) * (1.f / D) + EPS);
            f32x4* xr = (f32x4*)(out + (size_t)r * D) + lane; const f32x4* gr = (const f32x4*)g_final + lane;
#pragma unroll
            for (int j = 0; j < 4; ++j) xr[64 * j] = xr[64 * j] * gr[64 * j] * rstd;
        }
    }
#ifdef DIAG
    GBAR();
    if (bx == 0 && wave == 0 && lane_id_v() == 0) { const unsigned code = __hip_atomic_load(dg, __ATOMIC_RELAXED, __HIP_MEMORY_SCOPE_AGENT); if (code != 0x7fffffffu) out[0] = 100.f * (float)code; }
#endif
#undef IN
#undef SEAM
}

#ifndef N_LAUNCHES
#define N_LAUNCHES 1
#endif
extern "C" void kernel_launch(void* const* d_in, const int* in_sizes, int n_in, void* d_out, int out_size, void* d_ws, size_t ws_size, hipStream_t stream) {
    static int grid = 0;
    if (grid == 0) {
        if (n_in != 20 || out_size != S * D || ws_size < WS_END) { fprintf(stderr, "kernel_launch: unexpected shapes (n_in %d out %d ws %zu)\n", n_in, out_size, ws_size); grid = -1; return; }
        int dev = 0, cus = 0, per_cu = 0;
        hipGetDevice(&dev); hipDeviceGetAttribute(&cus, hipDeviceAttributeMultiprocessorCount, dev);
        if (hipFuncSetAttribute((const void*)fwd_kernel, hipFuncAttributeMaxDynamicSharedMemorySize, LDS_BYTES) != hipSuccess) { fprintf(stderr, "kernel_launch: hipFuncSetAttribute failed\n"); grid = -1; return; }
        if (hipOccupancyMaxActiveBlocksPerMultiprocessor(&per_cu, (const void*)fwd_kernel, NWAVES * 64, LDS_BYTES) != hipSuccess || per_cu < 1) per_cu = 1;
        (void)hipGetLastError();
        grid = cus * per_cu; if (grid > 256) grid = 256;
        fprintf(stderr, "kernel_launch: grid %d (cus %d per_cu %d)\n", grid, cus, per_cu);
    }
    if (grid < 0) return;
    Args a{};
    for (int i = 0; i < 20; ++i) a.in[i] = (const float*)d_in[i];
    a.out = (float*)d_out; a.ws = (unsigned char*)d_ws;
#if N_LAUNCHES == 1
    a.ph_lo = 0; a.ph_hi = 8;
    void* kargs[] = {&a};
    hipError_t e = hipLaunchCooperativeKernel((const void*)fwd_kernel, dim3(grid), dim3(NWAVES * 64), kargs, LDS_BYTES, stream);
    if (e != hipSuccess) fprintf(stderr, "cooperative launch failed: %s (grid %d)\n", hipGetErrorString(e), grid);
#else
    for (int p = 0; p < 8; ++p) { a.ph_lo = p; a.ph_hi = p + 1; hipLaunchKernelGGL(fwd_kernel, dim3(grid), dim3(NWAVES * 64), LDS_BYTES, stream, a); }
#endif
}
```

```cpp
#include <hip/hip_runtime.h>
#include <hip/hip_cooperative_groups.h>
#include <cstdio>
#include <cstdint>
namespace cg = cooperative_groups;

#define DI __device__ __forceinline__
#define LAS __attribute__((address_space(3)))
typedef unsigned short bf16_t;
typedef short bf16x8 __attribute__((ext_vector_type(8)));
typedef short s16x4 __attribute__((ext_vector_type(4)));
typedef float f32x2 __attribute__((ext_vector_type(2)));
typedef float f32x4 __attribute__((ext_vector_type(4)));
typedef float f32x16 __attribute__((ext_vector_type(16)));
typedef unsigned u32x2 __attribute__((ext_vector_type(2)));
typedef unsigned u32x4 __attribute__((ext_vector_type(4)));
typedef __bf16 bf16x2_t __attribute__((ext_vector_type(2)));

constexpr int S = 16384, D = 1024, DFF = 2816, NIN = 5120, NWAVES = 8;
constexpr float EPS = 1e-6f, LOG2E = 1.4426950408889634f, QSCALE = 0.125f * LOG2E;
constexpr int QKU_P = 1536, GATE_P = 3072;
constexpr size_t MiB = 1u << 20;
constexpr size_t WS_WIN = 0, WS_WUP = 10 * MiB, WS_WOUT = 12 * MiB, WS_WFUP = 14 * MiB, WS_WDN = 25 * MiB;
constexpr size_t WS_KM = 31 * MiB, WS_VMT = WS_KM + 131072, WS_PART = WS_VMT + 131072, WS_PART2 = WS_PART + MiB;
constexpr size_t WS_BAR = WS_PART2 + MiB;
constexpr size_t WS_R1 = 34 * MiB;
constexpr size_t WS_QKU = 67 * MiB, WS_GATES = 115 * MiB, WS_VT = 211 * MiB, WS_KF = 227 * MiB, WS_END = 245 * MiB;
constexpr size_t WS_MERGED = WS_QKU, WS_ACT = WS_QKU, WS_DUMP = 244 * MiB;
constexpr int LDS_RING = 131072, LDS_BIAS = LDS_RING, LDS_MISC = LDS_BIAS + 10496, LDS_BYTES = 147456;

DI unsigned pk2(float lo, float hi) { f32x2 v = {lo, hi}; bf16x2_t b = __builtin_convertvector(v, bf16x2_t); return __builtin_bit_cast(unsigned, b); }
DI float bflo(unsigned u) { return __builtin_bit_cast(float, u << 16); }
DI float bfhi(unsigned u) { return __builtin_bit_cast(float, u & 0xffff0000u); }
DI float wave_sum(float v) {
#pragma unroll
    for (int o = 1; o < 64; o <<= 1) v += __shfl_xor(v, o);
    return v;
}
DI unsigned long long rt_v() { unsigned long long t; asm volatile("s_memrealtime %0\n\ts_waitcnt lgkmcnt(0)" : "=s"(t) :: "memory"); return t; }
DI int lane_id_v() { int l; asm volatile("v_mbcnt_lo_u32_b32 %0, -1, 0\n\tv_mbcnt_hi_u32_b32 %0, -1, %0" : "=v"(l)); return l; }
DI float dpp_shr1(float v) { float r; asm volatile("s_nop 1\n\tv_mov_b32_dpp %0, %1 row_shr:1 row_mask:0xf bank_mask:0xf bound_ctrl:1\n\ts_nop 1" : "=&v"(r) : "v"(v)); return r; }
DI void half_swap(float& a, float& b) { asm volatile("s_nop 1\n\tv_permlane32_swap_b32 %0, %1\n\ts_nop 1" : "+v"(a), "+v"(b)); }
DI float xhalf_max(float m) { float a = m, b = m; half_swap(a, b); return fmaxf(a, b); }
DI float xhalf_sum(float m) { float a = m, b = m; half_swap(a, b); return a + b; }
DI f32x2 gelu_pk(f32x2 v) {
    const f32x2 av = __builtin_elementwise_abs(v), d = av * 0.2316418882f + 1.0f;
    f32x2 t; t.x = __builtin_amdgcn_rcpf(d.x); t.y = __builtin_amdgcn_rcpf(d.y);
    f32x2 q = t * 0.5307027145f + (-0.7265760135f); q = q * t + 0.7107068705f; q = q * t + (-0.142248368f); q = q * t + 0.127414796f; q = q * t;
    const f32x2 s = (v * v) * (-0.72134752044f);
    f32x2 e; e.x = __builtin_amdgcn_exp2f(s.x); e.y = __builtin_amdgcn_exp2f(s.y);
    const f32x2 m = v * (q * e), r = v - m;
    f32x2 o; o.x = v.x < 0.f ? m.x : r.x; o.y = v.y < 0.f ? m.y : r.y; return o;
}

namespace pg8 {
constexpr int BM = 256, BK = 64, HALF = 128, HTB = HALF * BK * 2, NXCD = 8, WGM = 8;
DI int lds_byte(int r, int c) { const int st = (r >> 4) * 2 + (c >> 5), rr = r & 15, cc = c & 31, ob = rr * 64 + cc * 2; return st * 1024 + (ob ^ (((ob >> 9) & 1) << 5)); }
DI void stage_rc(int b, int& R, int& C) { const int st = b / 1024, sb = b % 1024, swz = sb ^ (((sb >> 9) & 1) << 5); R = (st >> 1) * 16 + swz / 64; C = (st & 1) * 32 + (swz % 64) / 2; }
DI int perm32(int rho) { const int n = rho >> 4, i = rho & 15; return 8 * (i >> 2) + 4 * n + (i & 3); }
struct Unit { int pm, pn, idx; };
struct Gemm { const bf16_t* A; const bf16_t* Bt; int K; size_t a_tstep, a_hstep, b_tstep, b_hstep; };
struct StaticOrder {
    int nM, nN, nwg, G, c;
    DI void init(int nM_, int nN_, int G_, int c_) { nM = nM_; nN = nN_; nwg = nM * nN; G = G_; c = c_; }
    DI bool next(int i, Unit& u) const {
        const long L = (long)i * G + c; if (L >= nwg) return false;
        int wgid = (int)L; { const int q = nwg / NXCD, r = nwg % NXCD, xcd = wgid % NXCD, off = wgid / NXCD; wgid = (xcd < r ? xcd * (q + 1) : r * (q + 1) + (xcd - r) * q) + off; }
        const int nig = WGM * nN, gid = wgid / nig, fm = gid * WGM, gsz = (nM - fm) < WGM ? (nM - fm) : WGM;
        u.pm = fm + ((wgid % nig) % gsz); u.pn = (wgid % nig) / gsz; u.idx = i; return true;
    }
};
template <class Epi, class Sched>
DI void gemm_phase(LAS unsigned char* lds, const Gemm g, const Sched& S, const Epi& E, const int wid) {
    const int lane = lane_id_v();
    const int tid = wid * 64 + lane, wr = wid >> 2, wc = wid & 3, fr = lane & 15, fq = lane >> 4;
    const int K = g.K, nt = K / BK;
    unsigned voffA[2], voffB[2];
#pragma unroll
    for (int i = 0; i < 2; ++i) { int R, C; stage_rc(tid * 16 + i * 8192, R, C); const int Rb = (R & ~31) + perm32(R & 31);
        const int Ra = Epi::ROWPERM ? (126 * (R >> 6) + 8 * (R & 15) + ((R >> 4) & 3)) : R;
        voffA[i] = (unsigned)(Ra * K + C) * 2u; voffB[i] = (unsigned)(Rb * K + C) * 2u; }
    const size_t kstep = (size_t)(BK * 2);
    const size_t hstepA = g.a_hstep, hstepB = g.b_hstep;
    const unsigned ldsw = (unsigned)wid * 1024u;
    const int aoff = lds_byte(wr * 64 + fr, fq * 8), boff = lds_byte(wc * 32 + fr, fq * 8);
#define PG8_SA(b, h) (((b) * 2 + (h)) * HTB)
#define PG8_SB(b, h) ((4 + (b) * 2 + (h)) * HTB)
#define PG8_STAGE(bufoff, gbase, voff) do { _Pragma("unroll") for (int _i = 0; _i < 2; ++_i) \
        __builtin_amdgcn_global_load_lds((const unsigned*)((const char*)(gbase) + (voff)[_i]), (LAS unsigned*)(lds + (bufoff) + ldsw + _i * 8192), 16, 0, 0); } while (0)
#define PG8_LDA(dst, b, h) do { _Pragma("unroll") for (int m = 0; m < 4; ++m) _Pragma("unroll") for (int k = 0; k < 2; ++k) dst[m][k] = *(const LAS bf16x8*)(lds + PG8_SA(b, h) + aoff + m * 2048 + k * 1024); } while (0)
#define PG8_LDB(dst, b, h) do { _Pragma("unroll") for (int n = 0; n < 2; ++n) _Pragma("unroll") for (int k = 0; k < 2; ++k) dst[n][k] = *(const LAS bf16x8*)(lds + PG8_SB(b, h) + boff + n * 2048 + k * 1024); } while (0)
#define PG8_MMA(ai, bj, At, Bt) do { __builtin_amdgcn_s_setprio(1); _Pragma("unroll") for (int m = 0; m < 4; ++m) _Pragma("unroll") for (int n = 0; n < 2; ++n) _Pragma("unroll") for (int k = 0; k < 2; ++k) \
        acc[ai][bj][m][n] = __builtin_amdgcn_mfma_f32_16x16x32_bf16(Bt[n][k], At[m][k], acc[ai][bj][m][n], 0, 0, 0); __builtin_amdgcn_s_setprio(0); } while (0)
#define PG8_WAIT_V(n) asm volatile("s_waitcnt vmcnt(" #n ")" ::: "memory")
#define PG8_WAIT_L(n) asm volatile("s_waitcnt lgkmcnt(" #n ")" ::: "memory")
#define PG8_BAR __builtin_amdgcn_s_barrier()
#define PG8_SCHED __builtin_amdgcn_sched_barrier(0)
    Unit cur, nxt; int ui = 0;
    if (!S.next(0, cur)) return;
    f32x4 acc[2][2][4][2];
#pragma unroll
    for (int a = 0; a < 2; ++a)
#pragma unroll
        for (int b = 0; b < 2; ++b)
#pragma unroll
            for (int m = 0; m < 4; ++m)
#pragma unroll
                for (int n = 0; n < 2; ++n) acc[a][b][m][n] = (f32x4){0.f, 0.f, 0.f, 0.f};
    bf16x8 At[4][2], B0[2][2], B1[2][2];
    const char* cA = (const char*)g.A + (size_t)cur.pm * g.a_tstep; const char* cB = (const char*)g.Bt + (size_t)cur.pn * g.b_tstep;
    PG8_STAGE(PG8_SB(0, 0), cB, voffB); PG8_STAGE(PG8_SB(0, 1), cB + hstepB, voffB); PG8_STAGE(PG8_SA(0, 0), cA, voffA); PG8_STAGE(PG8_SA(0, 1), cA + hstepA, voffA);
    if (wr == 1) PG8_BAR;
    PG8_WAIT_V(2); PG8_BAR;
    PG8_STAGE(PG8_SB(1, 0), cB + kstep, voffB); PG8_STAGE(PG8_SA(1, 0), cA + kstep, voffA); PG8_STAGE(PG8_SB(1, 1), cB + hstepB + kstep, voffB);
    PG8_WAIT_V(6); PG8_BAR;
    for (;;) {
        const bool has_next = S.next(ui + 1, nxt);
        const char* nA = has_next ? (const char*)g.A + (size_t)nxt.pm * g.a_tstep : cA; const char* nB = has_next ? (const char*)g.Bt + (size_t)nxt.pn * g.b_tstep : cB;
        for (int t = 0; t < nt; t += 2) {
            const bool last = (t == nt - 2);
            const char* a1 = cA + (size_t)(t + 1) * kstep;
            const char* a2 = last ? nA : cA + (size_t)(t + 2) * kstep; const char* b2 = last ? nB : cB + (size_t)(t + 2) * kstep;
            const char* a3 = a2 + kstep; const char* b3 = b2 + kstep;
            if constexpr (Epi::HOOK) { if (t == 4 || t == 12) {
                    if (wr == 0) PG8_BAR; E.hook(acc, cur, t, wr, wc, fr, fq); if (wr == 1) PG8_BAR; } }
            PG8_LDB(B0, 0, 0); PG8_LDB(B1, 0, 1); PG8_SCHED; PG8_LDA(At, 0, 0); PG8_STAGE(PG8_SA(1, 1), a1 + hstepA, voffA);
            PG8_WAIT_V(8); PG8_WAIT_L(0); PG8_BAR; PG8_MMA(0, 0, At, B0); PG8_MMA(0, 1, At, B1); PG8_BAR; PG8_SCHED;
            PG8_LDA(At, 0, 1); PG8_STAGE(PG8_SB(0, 0), b2, voffB); PG8_STAGE(PG8_SB(0, 1), b2 + hstepB, voffB); PG8_STAGE(PG8_SA(0, 0), a2, voffA);
            PG8_WAIT_V(8); PG8_WAIT_L(0); PG8_BAR; PG8_MMA(1, 0, At, B0); PG8_MMA(1, 1, At, B1); PG8_BAR; PG8_SCHED;
            PG8_LDB(B0, 1, 0); PG8_LDB(B1, 1, 1); PG8_SCHED; PG8_LDA(At, 1, 0); PG8_STAGE(PG8_SA(0, 1), a2 + hstepA, voffA);
            PG8_WAIT_V(8); PG8_WAIT_L(0); PG8_BAR; PG8_MMA(0, 0, At, B0); PG8_MMA(0, 1, At, B1); PG8_BAR; PG8_SCHED;
            PG8_LDA(At, 1, 1); PG8_STAGE(PG8_SB(1, 0), b3, voffB); PG8_STAGE(PG8_SB(1, 1), b3 + hstepB, voffB); PG8_STAGE(PG8_SA(1, 0), a3, voffA);
            PG8_WAIT_V(8); PG8_WAIT_L(0); PG8_BAR; PG8_MMA(1, 0, At, B0); PG8_MMA(1, 1, At, B1); PG8_BAR; PG8_SCHED;
        }
        if (wr == 0) PG8_BAR;
        E(acc, cur, wr, wc, fr, fq);
        if (!has_next) break;
#pragma unroll
        for (int a = 0; a < 2; ++a)
#pragma unroll
            for (int b = 0; b < 2; ++b)
#pragma unroll
                for (int m = 0; m < 4; ++m)
#pragma unroll
                    for (int n = 0; n < 2; ++n) acc[a][b][m][n] = (f32x4){0.f, 0.f, 0.f, 0.f};
        cur = nxt; cA = nA; cB = nB; ++ui;
        if (wr == 1) PG8_BAR;
    }
    PG8_WAIT_V(0);
    PG8_BAR;
#undef PG8_SA
#undef PG8_SB
#undef PG8_STAGE
#undef PG8_LDA
#undef PG8_LDB
#undef PG8_MMA
#undef PG8_WAIT_V
#undef PG8_WAIT_L
#undef PG8_BAR
#undef PG8_SCHED
}
}
using pg8::Unit;
typedef f32x4 Acc[2][2][4][2];

DI u32x4 pack8(f32x4 a, f32x4 b) { u32x4 w; w.x = pk2(a[0], a[1]); w.y = pk2(a[2], a[3]); w.z = pk2(b[0], b[1]); w.w = pk2(b[2], b[3]); return w; }
DI float sigmoidf_(float x) { return __builtin_amdgcn_rcpf(1.f + __builtin_amdgcn_exp2f(-x * LOG2E)); }


DI size_t kf_elem(int NB, int head, int tok, int d) { return ((((size_t)(head * NB + (tok >> 5)) * 4 + (d >> 4)) * 64 + ((d >> 3) & 1) * 32 + (tok & 31)) << 3) + (d & 7); }
DI size_t vf_elem(int NB, int head, int tok, int d) { const int t = tok & 31; return (((((size_t)(head * NB + (tok >> 5)) * 2 + (d >> 5)) * 4 + (t >> 3)) * 64 + ((t >> 2) & 1) * 32 + (d & 31)) << 2) + (t & 3); }

struct EpiIn {
    static constexpr bool HOOK = false, ROWPERM = false;
    bf16_t* QKU; bf16_t* GATES; const float* b_gate; bf16_t* KF;
    DI void operator()(const Acc& acc, const Unit& u, int wr, int wc, int fr, int fq) const {
        const int row0 = u.pm * 256 + wr * 64 + fr, pn = u.pn;
        if (pn == 3 || pn == 4) {
#pragma unroll
            for (int ai = 0; ai < 2; ++ai)
#pragma unroll
                for (int m = 0; m < 4; ++m)
#pragma unroll
                    for (int bj = 0; bj < 2; ++bj) { const int tok = row0 + ai * 128 + m * 16, c = (pn - 3) * 256 + bj * 128 + wc * 32 + 8 * fq;
                        *(u32x4*)(KF + kf_elem(512, c >> 6, tok, c & 63)) = pack8(acc[ai][bj][m][0], acc[ai][bj][m][1]); }
            return; }
        if (pn >= 6) {
            const int col0 = (pn - 6) * 256 + wc * 32 + 8 * fq;
            f32x4 bv[2][2];
#pragma unroll
            for (int bj = 0; bj < 2; ++bj)
#pragma unroll
                for (int n = 0; n < 2; ++n) bv[bj][n] = *(const f32x4*)(b_gate + col0 + bj * 128 + 4 * n);
#pragma unroll
            for (int ai = 0; ai < 2; ++ai)
#pragma unroll
                for (int m = 0; m < 4; ++m) { bf16_t* rowp = GATES + (size_t)(row0 + ai * 128 + m * 16) * GATE_P + col0;
#pragma unroll
                    for (int bj = 0; bj < 2; ++bj) { f32x4 v0 = acc[ai][bj][m][0] + bv[bj][0], v1 = acc[ai][bj][m][1] + bv[bj][1];
#pragma unroll
                        for (int j = 0; j < 4; ++j) { v0[j] = fmaxf(sigmoidf_(v0[j]), 1e-9f); v1[j] = fmaxf(sigmoidf_(v1[j]), 1e-9f); }
                        *(u32x4*)(rowp + bj * 128) = pack8(v0, v1); } }
            return; }
        const float sc = (pn == 1 || pn == 2 || pn == 5) ? QSCALE : 1.f;
        const int col0 = pn * 256 + wc * 32 + 8 * fq;
#pragma unroll
        for (int ai = 0; ai < 2; ++ai)
#pragma unroll
            for (int m = 0; m < 4; ++m) { bf16_t* rowp = QKU + (size_t)(row0 + ai * 128 + m * 16) * QKU_P + col0;
#pragma unroll
                for (int bj = 0; bj < 2; ++bj) *(u32x4*)(rowp + bj * 128) = pack8(acc[ai][bj][m][0] * sc, acc[ai][bj][m][1] * sc); }
    }
};
struct EpiVT {
    static constexpr bool HOOK = false, ROWPERM = false;
    bf16_t* VF;
    DI void operator()(const Acc& acc, const Unit& u, int wr, int wc, int fr, int fq) const {
        const int row0 = u.pm * 256 + wr * 64 + fr, col0 = u.pn * 256 + wc * 32 + 8 * fq;
#pragma unroll
        for (int ai = 0; ai < 2; ++ai)
#pragma unroll
            for (int m = 0; m < 4; ++m) { const int hd = row0 + ai * 128 + m * 16;
#pragma unroll
                for (int bj = 0; bj < 2; ++bj) { const int tok = col0 + bj * 128;
                    u32x2 w0, w1; w0.x = pk2(acc[ai][bj][m][0][0], acc[ai][bj][m][0][1]); w0.y = pk2(acc[ai][bj][m][0][2], acc[ai][bj][m][0][3]);
                    w1.x = pk2(acc[ai][bj][m][1][0], acc[ai][bj][m][1][1]); w1.y = pk2(acc[ai][bj][m][1][2], acc[ai][bj][m][1][3]);
                    *(u32x2*)(VF + vf_elem(512, hd >> 6, tok, hd & 63)) = w0; *(u32x2*)(VF + vf_elem(512, hd >> 6, tok + 4, hd & 63)) = w1; } }
    }
};
struct EpiMerge {
    static constexpr bool HOOK = true, ROWPERM = false;
    const bf16_t* GATES; bf16_t* MERGED;
    DI void hook(Acc& acc, const Unit& u, int t, int wr, int wc, int fr, int fq) const {
        int row0 = u.pm * 256 + wr * 64 + fr; const int col0 = u.pn * 256 + wc * 32 + 8 * fq;
        asm volatile("" : "+v"(row0));
        const int ga = (t == 4) ? 0 : D, gb = ga + D;
#pragma unroll
        for (int ai = 0; ai < 2; ++ai)
#pragma unroll
            for (int m = 0; m < 4; ++m) { const bf16_t* gp = GATES + (size_t)(row0 + ai * 128 + m * 16) * GATE_P + col0;
#pragma unroll
                for (int bj = 0; bj < 2; ++bj) { const u32x4 a = *(const u32x4*)(gp + ga + bj * 128), b = *(const u32x4*)(gp + gb + bj * 128);
                    f32x4 r0, r1;
                    r0[0] = bflo(a.x) * __builtin_amdgcn_rcpf(bflo(b.x)); r0[1] = bfhi(a.x) * __builtin_amdgcn_rcpf(bfhi(b.x));
                    r0[2] = bflo(a.y) * __builtin_amdgcn_rcpf(bflo(b.y)); r0[3] = bfhi(a.y) * __builtin_amdgcn_rcpf(bfhi(b.y));
                    r1[0] = bflo(a.z) * __builtin_amdgcn_rcpf(bflo(b.z)); r1[1] = bfhi(a.z) * __builtin_amdgcn_rcpf(bfhi(b.z));
                    r1[2] = bflo(a.w) * __builtin_amdgcn_rcpf(bflo(b.w)); r1[3] = bfhi(a.w) * __builtin_amdgcn_rcpf(bfhi(b.w));
                    acc[ai][bj][m][0] = acc[ai][bj][m][0] * r0; acc[ai][bj][m][1] = acc[ai][bj][m][1] * r1; } }
    }
    DI void operator()(const Acc& acc, const Unit& u, int wr, int wc, int fr, int fq) const {
        const int row0 = u.pm * 256 + wr * 64 + fr, col0 = u.pn * 256 + wc * 32 + 8 * fq;
#pragma unroll
        for (int ai = 0; ai < 2; ++ai)
#pragma unroll
            for (int m = 0; m < 4; ++m) { const size_t row = (size_t)(row0 + ai * 128 + m * 16);
#pragma unroll
                for (int bj = 0; bj < 2; ++bj) { const u32x4 a = *(const u32x4*)(GATES + row * GATE_P + 2 * D + col0 + bj * 128);
                    const f32x4 g0 = {bflo(a.x), bfhi(a.x), bflo(a.y), bfhi(a.y)}, g1 = {bflo(a.z), bfhi(a.z), bflo(a.w), bfhi(a.w)};
                    *(u32x4*)(MERGED + row * D + col0 + bj * 128) = pack8(acc[ai][bj][m][0] * g0, acc[ai][bj][m][1] * g1); } }
    }
};
template <bool IN_BF16>
struct EpiResid {
    static constexpr bool HOOK = false, ROWPERM = false;
    const float* XI; bf16_t* XB; float* PART;
    DI void operator()(const Acc& acc, const Unit& u, int wr, int wc, int fr, int fq) const {
        const int row0 = u.pm * 256 + wr * 64 + fr, col0 = u.pn * 256 + wc * 32 + 8 * fq;
#pragma unroll
        for (int ai = 0; ai < 2; ++ai) {
            f32x4 xin[4][2][2];
#pragma unroll
            for (int m = 0; m < 4; ++m)
#pragma unroll
                for (int bj = 0; bj < 2; ++bj) { const size_t off = (size_t)(row0 + ai * 128 + m * 16) * D + col0 + bj * 128;
                    if (IN_BF16) { const u32x4 a = *(const u32x4*)(XB + off); xin[m][bj][0] = (f32x4){bflo(a.x), bfhi(a.x), bflo(a.y), bfhi(a.y)}; xin[m][bj][1] = (f32x4){bflo(a.z), bfhi(a.z), bflo(a.w), bfhi(a.w)}; }
                    else { xin[m][bj][0] = *(const f32x4*)(XI + off); xin[m][bj][1] = *(const f32x4*)(XI + off + 4); } }
            __builtin_amdgcn_sched_barrier(0);
#pragma unroll
            for (int m = 0; m < 4; ++m) { const size_t row = (size_t)(row0 + ai * 128 + m * 16); float ss = 0.f;
#pragma unroll
                for (int bj = 0; bj < 2; ++bj) { const size_t off = row * D + col0 + bj * 128;
                    const f32x4 v0 = xin[m][bj][0] + acc[ai][bj][m][0], v1 = xin[m][bj][1] + acc[ai][bj][m][1];
                    *(u32x4*)(XB + off) = pack8(v0, v1);
                    ss += (v0[0] * v0[0] + v0[1] * v0[1]) + (v0[2] * v0[2] + v0[3] * v0[3]) + (v1[0] * v1[0] + v1[1] * v1[1]) + (v1[2] * v1[2] + v1[3] * v1[3]); }
                ss += __shfl_xor(ss, 16); ss += __shfl_xor(ss, 32);
                if (fq == 0) PART[row * 16 + u.pn * 4 + wc] = ss; }
        }
    }
};
struct EpiFfnUp {
    static constexpr bool HOOK = false, ROWPERM = true;
    bf16_t* ACT; const LAS float* RS; const float* conv_w; const float* conv_b; bf16_t* DUMP;
    DI void operator()(const Acc& acc, const Unit& u, int wr, int wc, int fr, int fq) const {
        const int r0 = 252 * u.pm - 2 + 126 * wr + 8 * fr;
        float rs[8];
        const LAS float* rsp = RS + (u.idx * 256 + wr * 128 + 8 * fr);
        { const f32x4 ra = *(const LAS f32x4*)rsp, rb = *(const LAS f32x4*)(rsp + 4); rs[0] = ra[0]; rs[1] = ra[1]; rs[2] = ra[2]; rs[3] = ra[3]; rs[4] = rb[0]; rs[5] = rb[1]; rs[6] = rb[2]; rs[7] = rb[3]; }
        const int j0 = 128 * u.pn + 32 * wc + 8 * fq;
#pragma unroll
        for (int n = 0; n < 2; ++n) {
            const int jc = j0 + 4 * n;
            const f32x4 wg0 = *(const f32x4*)(conv_w + jc), wg1 = *(const f32x4*)(conv_w + 2 * DFF + jc), wg2 = *(const f32x4*)(conv_w + 4 * DFF + jc), bg = *(const f32x4*)(conv_b + jc);
            const f32x4 wv0 = *(const f32x4*)(conv_w + DFF + jc), wv1 = *(const f32x4*)(conv_w + 3 * DFF + jc), wv2 = *(const f32x4*)(conv_w + 5 * DFF + jc), bv = *(const f32x4*)(conv_b + DFF + jc);
            f32x4 g[8], v[8];
#pragma unroll
            for (int i = 0; i < 8; ++i) { g[i] = acc[i >> 2][0][i & 3][n] * rs[i]; v[i] = acc[i >> 2][1][i & 3][n] * rs[i]; }
            f32x4 gp6, gp7, vp6, vp7;
#pragma unroll
            for (int j = 0; j < 4; ++j) {
                gp6[j] = dpp_shr1(g[6][j]);
                gp7[j] = dpp_shr1(g[7][j]);
                vp6[j] = dpp_shr1(v[6][j]);
                vp7[j] = dpp_shr1(v[7][j]); }
#pragma unroll
            for (int i = 7; i >= 0; --i) {
                const f32x4 gm1 = (i >= 1) ? g[i - 1] : gp7, gm2 = (i >= 2) ? g[i - 2] : (i == 1 ? gp7 : gp6);
                const f32x4 vm1 = (i >= 1) ? v[i - 1] : vp7, vm2 = (i >= 2) ? v[i - 2] : (i == 1 ? vp7 : vp6);
                const f32x4 cg = bg + wg2 * g[i] + wg1 * gm1 + wg0 * gm2;
                const f32x4 cv = bv + wv2 * v[i] + wv1 * vm1 + wv0 * vm2;
                const f32x2 ga = gelu_pk((f32x2){cg[0], cg[1]}), gb = gelu_pk((f32x2){cg[2], cg[3]});
                const int row = r0 + i;
                u32x2 w; w.x = pk2(ga.x * cv[0], ga.y * cv[1]); w.y = pk2(gb.x * cv[2], gb.y * cv[3]);
                bf16_t* dst = ((8 * fr + i >= 2) && row < S) ? ACT + (size_t)row * DFF + jc : DUMP + (((wr * 4 + wc) * 64 + fq * 16 + fr) << 2);
                *(u32x2*)dst = w;
            }
        }
    }
};

#define MFMA32(a, b, c) __builtin_amdgcn_mfma_f32_32x32x16_bf16((a), (b), (c), 0, 0, 0)
DI int crow(int i, int g) { return (i & 3) + 8 * (i >> 2) + 4 * g; }
DI void attn_step(bf16x8 (&kf)[4], const char* kbase, unsigned& koff, const s16x4 (&v0)[4], const s16x4 (&v1)[4], const LAS bf16x8* ql, f32x16 (&o)[2][2], float (&mrun)[2], float (&lrun)[2],
                  int it, int jt0, const LAS float* bias, bool has_bias, int r, int g) {
    f32x16 s[2];
#pragma unroll
    for (int qb = 0; qb < 2; ++qb)
#pragma unroll
        for (int i = 0; i < 16; ++i) s[qb][i] = 0.f;
#pragma unroll
    for (int st = 0; st < 4; ++st) {
        if ((st & 1) == 0) asm volatile("" ::: "memory");
#pragma unroll
        for (int qb = 0; qb < 2; ++qb) s[qb] = MFMA32(kf[st], ql[(qb * 4 + st) * 64], s[qb]);
    }
    koff += 4096u;
#pragma unroll
    for (int st = 0; st < 4; ++st) kf[st] = *(const bf16x8*)(kbase + koff + 1024 * st);
    if (has_bias) { const int jt = jt0 + (it >> 1);
        if (jt <= 5) { const float c = bias[256];
#pragma unroll
            for (int qb = 0; qb < 2; ++qb)
#pragma unroll
                for (int i = 0; i < 16; ++i) s[qb][i] += c;
        } else { const LAS float* bp = bias + (64 * (8 - jt) + 128 - 32 * (it & 1) + r - 4 * g - 27);
#pragma unroll
            for (int qb = 0; qb < 2; ++qb)
#pragma unroll
                for (int i = 0; i < 16; ++i) s[qb][i] += bp[27 + 32 * qb - ((i & 3) + 8 * (i >> 2))];
        } }
    float mn[2];
#pragma unroll
    for (int qb = 0; qb < 2; ++qb) {
        float m = fmaxf(fmaxf(s[qb][0], s[qb][1]), s[qb][2]);
#pragma unroll
        for (int i = 3; i < 15; i += 2) m = fmaxf(fmaxf(m, s[qb][i]), s[qb][i + 1]);
        m = fmaxf(m, s[qb][15]);
        mn[qb] = fmaxf(mrun[qb], xhalf_max(m));
    }
    if (__any((mn[0] > mrun[0]) || (mn[1] > mrun[1]))) {
#pragma unroll
        for (int qb = 0; qb < 2; ++qb) {
            const float al = __builtin_amdgcn_exp2f(mrun[qb] - mn[qb]); mrun[qb] = mn[qb];
            lrun[qb] *= al;
#pragma unroll
            for (int db = 0; db < 2; ++db)
#pragma unroll
                for (int i = 0; i < 16; ++i) o[db][qb][i] *= al;
        }
    }
#pragma unroll
    for (int qb = 0; qb < 2; ++qb) {
        float ls = 0.f;
#pragma unroll
        for (int i = 0; i < 16; ++i) { const float p = __builtin_amdgcn_exp2f(s[qb][i] - mn[qb]); s[qb][i] = p; ls += p; }
        lrun[qb] += ls;
    }
#pragma unroll
    for (int sp = 0; sp < 2; ++sp) {
        bf16x8 pf[2];
#pragma unroll
        for (int qb = 0; qb < 2; ++qb) { u32x4 w; w.x = pk2(s[qb][8 * sp + 0], s[qb][8 * sp + 1]); w.y = pk2(s[qb][8 * sp + 2], s[qb][8 * sp + 3]);
            w.z = pk2(s[qb][8 * sp + 4], s[qb][8 * sp + 5]); w.w = pk2(s[qb][8 * sp + 6], s[qb][8 * sp + 7]); pf[qb] = __builtin_bit_cast(bf16x8, w); }
        const bf16x8 vf0 = __builtin_shufflevector(v0[2 * sp], v0[2 * sp + 1], 0, 1, 2, 3, 4, 5, 6, 7);
        const bf16x8 vf1 = __builtin_shufflevector(v1[2 * sp], v1[2 * sp + 1], 0, 1, 2, 3, 4, 5, 6, 7);
#pragma unroll
        for (int qb = 0; qb < 2; ++qb) { o[0][qb] = MFMA32(vf0, pf[qb], o[0][qb]); o[1][qb] = MFMA32(vf1, pf[qb], o[1][qb]); }
    }
}
#define ATTN_LOADV(v0_, v1_) do { _Pragma("unroll") for (int j = 0; j < 4; ++j) { v0_[j] = *(const s16x4*)(vbase + voff + 512 * j); v1_[j] = *(const s16x4*)(vbase + voff + 2048 + 512 * j); } voff += 4096u; } while (0)
DI void attn_wave(const bf16_t* Q, int qp, const bf16_t* KFp, const bf16_t* VFp, int nsteps, int jt0,
                  const LAS float* bias, bool has_bias, bf16_t* O, int op, int lane_in, LAS unsigned char* qlds) {
    int lane = lane_in; asm volatile("" : "+v"(lane));
    const int r = lane & 31, g = lane >> 5;
    LAS bf16x8* ql = (LAS bf16x8*)qlds + lane;
#pragma unroll
    for (int qb = 0; qb < 2; ++qb)
#pragma unroll
        for (int st = 0; st < 4; ++st) ql[(qb * 4 + st) * 64] = *(const bf16x8*)(Q + (size_t)(32 * qb + r) * qp + 16 * st + 8 * g);
    f32x16 o[2][2]; float mrun[2] = {-1e30f, -1e30f}, lrun[2] = {0.f, 0.f};
#pragma unroll
    for (int a = 0; a < 2; ++a)
#pragma unroll
        for (int b = 0; b < 2; ++b)
#pragma unroll
            for (int i = 0; i < 16; ++i) o[a][b][i] = 0.f;
    const char* kbase = (const char*)KFp; const char* vbase = (const char*)VFp;
    unsigned koff = (unsigned)lane * 16u, voff = (unsigned)lane * 8u;
    bf16x8 kf[4]; s16x4 v0A[4], v1A[4], v0B[4], v1B[4];
#pragma unroll
    for (int st = 0; st < 4; ++st) kf[st] = *(const bf16x8*)(kbase + koff + 1024 * st);
    ATTN_LOADV(v0A, v1A);
    for (int it = 0; it < nsteps; it += 2) {
        ATTN_LOADV(v0B, v1B);
        attn_step(kf, kbase, koff, v0A, v1A, ql, o, mrun, lrun, it, jt0, bias, has_bias, r, g);
        ATTN_LOADV(v0A, v1A);
        attn_step(kf, kbase, koff, v0B, v1B, ql, o, mrun, lrun, it + 1, jt0, bias, has_bias, r, g);
    }
    int l2 = lane; asm volatile("" : "+v"(l2));
    const int r2 = l2 & 31, g2 = l2 >> 5;
#pragma unroll
    for (int qb = 0; qb < 2; ++qb) { const float inv = 1.f / xhalf_sum(lrun[qb]);
#pragma unroll
        for (int db = 0; db < 2; ++db)
#pragma unroll
            for (int ig = 0; ig < 4; ++ig) { u32x2 w; w.x = pk2(o[db][qb][4 * ig] * inv, o[db][qb][4 * ig + 1] * inv); w.y = pk2(o[db][qb][4 * ig + 2] * inv, o[db][qb][4 * ig + 3] * inv);
                *(u32x2*)(O + (size_t)(32 * qb + r2) * op + 32 * db + 8 * ig + 4 * g2) = w; } }
}

template <int WIN> DI void pool_lane(const bf16_t* U, bf16_t* OC, int t0) {
    u32x4 rows[WIN + 7];
#pragma unroll
    for (int j = 0; j < WIN + 7; ++j) { const int t = t0 - WIN + 1 + j; rows[j] = (t >= 0) ? *(const u32x4*)(U + (size_t)t * QKU_P) : (u32x4){0u, 0u, 0u, 0u}; }
    float sm[8];
#pragma unroll
    for (int c = 0; c < 8; ++c) sm[c] = 0.f;
#pragma unroll
    for (int j = 0; j < WIN; ++j) { const u32x4 a = rows[j];
        sm[0] += bflo(a.x); sm[1] += bfhi(a.x); sm[2] += bflo(a.y); sm[3] += bfhi(a.y); sm[4] += bflo(a.z); sm[5] += bfhi(a.z); sm[6] += bflo(a.w); sm[7] += bfhi(a.w); }
#pragma unroll
    for (int k = 0; k < 8; ++k) { const int t = t0 + k; const u32x4 a = rows[k + WIN - 1];
        if (k > 0) { const u32x4 b = rows[k - 1];
            sm[0] += bflo(a.x) - bflo(b.x); sm[1] += bfhi(a.x) - bfhi(b.x); sm[2] += bflo(a.y) - bflo(b.y); sm[3] += bfhi(a.y) - bfhi(b.y);
            sm[4] += bflo(a.z) - bflo(b.z); sm[5] += bfhi(a.z) - bfhi(b.z); sm[6] += bflo(a.w) - bflo(b.w); sm[7] += bfhi(a.w) - bfhi(b.w); }
        const float ic = 1.f / (float)((t + 1 < WIN) ? t + 1 : WIN);
        u32x4 w; w.x = pk2(sm[0] * ic - bflo(a.x), sm[1] * ic - bfhi(a.x)); w.y = pk2(sm[2] * ic - bflo(a.y), sm[3] * ic - bfhi(a.y));
        w.z = pk2(sm[4] * ic - bflo(a.z), sm[5] * ic - bfhi(a.z)); w.w = pk2(sm[6] * ic - bflo(a.w), sm[7] * ic - bfhi(a.w));
        *(u32x4*)(OC + (size_t)t * D) = w; }
}

DI void transpose_item(const float* W, int N, bf16_t* WT, int ldt, int koff, int row_off, const float* kscale, LAS float* scr, int kb, int nb, int lane) {
    const int k0 = 64 * kb, n0 = 32 * nb;
    const float* wp = W + (size_t)(k0 + (lane >> 5)) * N + n0 + (lane & 31);
    float v[32];
#pragma unroll
    for (int i = 0; i < 32; ++i) v[i] = wp[(size_t)(2 * i) * N];
#pragma unroll
    for (int i = 0; i < 32; ++i) scr[(2 * i + (lane >> 5)) * 33 + (lane & 31)] = v[i];
    asm volatile("s_waitcnt lgkmcnt(0)" ::: "memory");
    const int c = lane & 7;
    float gs[8];
#pragma unroll
    for (int j = 0; j < 8; ++j) gs[j] = kscale ? kscale[k0 + 8 * c + j] : 1.f;
#pragma unroll
    for (int j = 0; j < 4; ++j) { const int n = (lane >> 3) + 8 * j; const LAS float* s = scr + (8 * c) * 33 + n;
        u32x4 o; o.x = pk2(s[0 * 33] * gs[0], s[1 * 33] * gs[1]); o.y = pk2(s[2 * 33] * gs[2], s[3 * 33] * gs[3]); o.z = pk2(s[4 * 33] * gs[4], s[5 * 33] * gs[5]); o.w = pk2(s[6 * 33] * gs[6], s[7 * 33] * gs[7]);
        *(u32x4*)(WT + (size_t)(row_off + n0 + n) * ldt + koff + k0 + 8 * c) = o; }
    asm volatile("s_waitcnt lgkmcnt(0)" ::: "memory");
}

#define XB_TMO      128
#define XB_XCNT(j)  (256  + 64 * (j))
#define XB_XSUB(j)  (1280 + 64 * (j))
#define XB_XGEN(j)  (2304 + 64 * (j))
#define XB_TOP      3328
#define XB_TOPGEN   3392
#define XCD_BAR_WORDS 3456
#define XB_SPIN_CAP (1u << 20)
DI unsigned xb_ld(unsigned* p)              { return __hip_atomic_load(p, __ATOMIC_RELAXED, __HIP_MEMORY_SCOPE_AGENT); }
DI unsigned xb_add(unsigned* p, unsigned v) { return __hip_atomic_fetch_add(p, v, __ATOMIC_RELAXED, __HIP_MEMORY_SCOPE_AGENT); }
DI unsigned xb_xcc_id() { return (unsigned)__builtin_amdgcn_s_getreg((3 << 11) | 20) & 0xFu; }
#define XB_SPIN(cond, bar) do { unsigned _sp = 0; while (cond) { __builtin_amdgcn_s_sleep(1); \
    if ((++_sp & 255u) == 0u) { if (xb_ld(&(bar)[XB_TMO])) break; if (_sp > XB_SPIN_CAP) { atomicAdd(&(bar)[XB_TMO], 1u); break; } } } } while (0)
DI void xcd_barrier_complete(unsigned* bar, unsigned x, unsigned G, unsigned& nloc, unsigned& nx) {
    unsigned sum, cnt, mine, sp = 0u;
    for (;;) {
        sum = 0u; cnt = 0u; mine = 0u;
#pragma unroll
        for (unsigned j = 0; j < 16; ++j) { const unsigned c = xb_ld(&bar[XB_XCNT(j)]); sum += c; cnt += (c > 0u) ? 1u : 0u; mine = (j == x) ? c : mine; }
        if (sum == G) break;
        __builtin_amdgcn_s_sleep(1);
        if ((++sp & 255u) == 0u) { if (xb_ld(&bar[XB_TMO])) break; if (sp > XB_SPIN_CAP) { atomicAdd(&bar[XB_TMO], 1u); break; } }
    }
    nloc = mine > 0u ? mine : 1u; nx = cnt > 0u ? cnt : 1u;
}
DI void grid_bar(unsigned* bar, volatile LAS unsigned* st, unsigned G, int wave) {
    asm volatile("s_waitcnt vmcnt(0)" ::: "memory");
    __syncthreads();
    if (wave == 0) { if (lane_id_v() == 0) {
        __builtin_amdgcn_s_waitcnt(0);
        const unsigned x = xb_xcc_id();
        unsigned nloc = st[0], nx = st[1];
        if (nloc == 0u) { xcd_barrier_complete(bar, x, G, nloc, nx); st[0] = nloc; st[1] = nx; }
        const unsigned old = xb_add(&bar[XB_XSUB(x)], 1u);
        const unsigned gen = old / nloc;
        if (old + 1u == (gen + 1u) * nloc) {
            __builtin_amdgcn_fence(__ATOMIC_RELEASE, "agent");
            asm volatile("s_waitcnt vmcnt(0)" ::: "memory");
            const unsigned og = xb_add(&bar[XB_TOP], 1u);
            const unsigned tg = og / nx;
            if (og + 1u == (tg + 1u) * nx) xb_add(&bar[XB_TOPGEN], 1u);
            else XB_SPIN(xb_ld(&bar[XB_TOPGEN]) == tg, bar);
            __builtin_amdgcn_fence(__ATOMIC_ACQUIRE, "agent");
            xb_add(&bar[XB_XGEN(x)], 1u);
            asm volatile("s_waitcnt vmcnt(0)" ::: "memory");
        } else {
            XB_SPIN(xb_ld(&bar[XB_XGEN(x)]) == gen, bar);
            __builtin_amdgcn_fence(__ATOMIC_ACQUIRE, "agent");
            asm volatile("s_waitcnt vmcnt(0)" ::: "memory");
        }
    } }
    __syncthreads();
}

struct EpiFinal {
    static constexpr bool HOOK = false, ROWPERM = false;
    const bf16_t* XB; float* OUT; float* PARTF; unsigned* CNT; const float* gfin; unsigned* tmo;
    DI void operator()(Acc& acc, const Unit& u, int wr, int wc, int fr, int fq) const {
        const int row0 = u.pm * 256 + wr * 64 + fr, col0 = u.pn * 256 + wc * 32 + 8 * fq;
        u32x4 xin[16];
#pragma unroll
        for (int ai = 0; ai < 2; ++ai)
#pragma unroll
            for (int m = 0; m < 4; ++m)
#pragma unroll
                for (int bj = 0; bj < 2; ++bj) xin[(ai * 4 + m) * 2 + bj] = *(const u32x4*)(XB + (size_t)(row0 + ai * 128 + m * 16) * D + col0 + bj * 128);
        __builtin_amdgcn_sched_barrier(0);
#pragma unroll
        for (int ai = 0; ai < 2; ++ai)
#pragma unroll
            for (int m = 0; m < 4; ++m) { const size_t row = (size_t)(row0 + ai * 128 + m * 16); float ss = 0.f;
#pragma unroll
                for (int bj = 0; bj < 2; ++bj) { const u32x4 a = xin[(ai * 4 + m) * 2 + bj];
                    const f32x4 v0 = (f32x4){bflo(a.x), bfhi(a.x), bflo(a.y), bfhi(a.y)} + acc[ai][bj][m][0], v1 = (f32x4){bflo(a.z), bfhi(a.z), bflo(a.w), bfhi(a.w)} + acc[ai][bj][m][1];
                    acc[ai][bj][m][0] = v0; acc[ai][bj][m][1] = v1;
                    ss += (v0[0] * v0[0] + v0[1] * v0[1]) + (v0[2] * v0[2] + v0[3] * v0[3]) + (v1[0] * v1[0] + v1[1] * v1[1]) + (v1[2] * v1[2] + v1[3] * v1[3]); }
                ss += __shfl_xor(ss, 16); ss += __shfl_xor(ss, 32);
                if (fq == 0) PARTF[((size_t)u.pn * S + row) * 4 + wc] = ss; }
        asm volatile("s_waitcnt vmcnt(0)" ::: "memory");
        __builtin_amdgcn_s_barrier();
        if (wr == 0 && wc == 0) { if (lane_id_v() == 0) {
            __builtin_amdgcn_fence(__ATOMIC_RELEASE, "agent");
            asm volatile("s_waitcnt vmcnt(0)" ::: "memory");
            xb_add(CNT + 64 * u.pm, 1u);
            XB_SPIN(xb_ld(CNT + 64 * u.pm) < 4u, tmo - XB_TMO);
            __builtin_amdgcn_fence(__ATOMIC_ACQUIRE, "agent");
            asm volatile("s_waitcnt vmcnt(0)" ::: "memory");
        } }
        __builtin_amdgcn_s_barrier();
        asm volatile("" ::: "memory");
        f32x4 gv[2][2];
#pragma unroll
        for (int bj = 0; bj < 2; ++bj)
#pragma unroll
            for (int n = 0; n < 2; ++n) gv[bj][n] = *(const f32x4*)(gfin + col0 + bj * 128 + 4 * n);
#pragma unroll
        for (int ai = 0; ai < 2; ++ai)
#pragma unroll
            for (int m = 0; m < 4; ++m) { const size_t row = (size_t)(row0 + ai * 128 + m * 16);
                const f32x4 p0 = *(const f32x4*)(PARTF + ((size_t)0 * S + row) * 4), p1 = *(const f32x4*)(PARTF + ((size_t)1 * S + row) * 4),
                            p2 = *(const f32x4*)(PARTF + ((size_t)2 * S + row) * 4), p3 = *(const f32x4*)(PARTF + ((size_t)3 * S + row) * 4);
                const f32x4 t = (p0 + p1) + (p2 + p3);
                const float rstd = __builtin_amdgcn_rsqf(((t[0] + t[1]) + (t[2] + t[3])) * (1.f / D) + EPS);
#pragma unroll
                for (int bj = 0; bj < 2; ++bj) { float* op = OUT + row * D + col0 + bj * 128;
                    *(f32x4*)op = acc[ai][bj][m][0] * gv[bj][0] * rstd; *(f32x4*)(op + 4) = acc[ai][bj][m][1] * gv[bj][1] * rstd; } }
    }
};

#ifdef DIAG
DI float bfv(const bf16_t* p) { return __builtin_bit_cast(float, (unsigned)(*p) << 16); }
DI float dotbb(const bf16_t* a, const bf16_t* b, int n) { float s = 0.f; for (int k = 0; k < n; ++k) s += bfv(a + k) * bfv(b + k); return s; }
DI unsigned hsh(unsigned x) { x ^= x >> 16; x *= 0x7feb352du; x ^= x >> 15; x *= 0x846ca68bu; x ^= x >> 16; return x; }
DI int srow(int tid) { return tid < 64 ? ((tid & 7) + 126 * (tid >> 3)) : (tid < 80 ? S - 1 - (tid - 64) : (int)(hsh(tid) % S)); }
DI void chk(unsigned* dg, int code, float got, float exp, float rel, float abs_) { if (!(fabsf(got - exp) <= rel * fabsf(exp) + abs_)) atomicMin(dg, (unsigned)code); }
#define DCHK(code, got, exp, rel, abs_) chk(dg, code, got, exp, rel, abs_)
#endif

struct Args { const float* in[20]; float* out; unsigned char* ws; int ph_lo, ph_hi; };

__global__ void __launch_bounds__(NWAVES * 64, 2) fwd_kernel(Args args) {
    extern __shared__ __attribute__((aligned(16))) unsigned char lds_raw[];
    LAS unsigned char* lds = (LAS unsigned char*)lds_raw;
    cg::grid_group grid = cg::this_grid();
    const int wave = __builtin_amdgcn_readfirstlane((int)threadIdx.x >> 6);
    const int G = gridDim.x, bx = blockIdx.x;
    const int vcu = (G % 8 == 0) ? (bx % 8) * (G / 8) + bx / 8 : bx;
    unsigned char* ws = args.ws;
    const float* x = args.in[0]; const float* mem = args.in[1]; const float* g_mix = args.in[2]; const float* g_mem = args.in[3];
    const float* w_in = args.in[4]; const float* b_gate = args.in[5]; const float* w_pool = args.in[6]; const float* pool_scale = args.in[7];
    const float* rel_bias = args.in[8]; const float* w_mem_kv = args.in[9]; const float* w_up_pool = args.in[10]; const float* w_up_attn = args.in[11];
    const float* w_up_mem = args.in[12]; const float* w_out = args.in[13]; const float* g_ffn = args.in[14]; const float* w_ffn_up = args.in[15];
    const float* conv_w = args.in[16]; const float* conv_b = args.in[17]; const float* w_ffn_down = args.in[18]; const float* g_final = args.in[19];
    float* out = args.out;
    bf16_t* WIN = (bf16_t*)(ws + WS_WIN); bf16_t* WUP = (bf16_t*)(ws + WS_WUP); bf16_t* WOUT = (bf16_t*)(ws + WS_WOUT); bf16_t* WFUP = (bf16_t*)(ws + WS_WFUP); bf16_t* WDN = (bf16_t*)(ws + WS_WDN);
    bf16_t* KM = (bf16_t*)(ws + WS_KM); bf16_t* VMT = (bf16_t*)(ws + WS_VMT); float* PART = (float*)(ws + WS_PART); float* PART2 = (float*)(ws + WS_PART2);
    bf16_t* R1 = (bf16_t*)(ws + WS_R1); bf16_t* QKU = (bf16_t*)(ws + WS_QKU); bf16_t* GATES = (bf16_t*)(ws + WS_GATES); bf16_t* VTb = (bf16_t*)(ws + WS_VT); bf16_t* KFb = (bf16_t*)(ws + WS_KF);
    bf16_t* MERGED = (bf16_t*)(ws + WS_MERGED); bf16_t* ACT = (bf16_t*)(ws + WS_ACT);
    const int lo = args.ph_lo, hi = args.ph_hi;
#define IN(k) (lo <= (k) && (k) < hi)
#ifdef REPEAT_PHASE
#define REP(k) (((k) == REPEAT_PHASE) ? 2 : 1)
#else
#define REP(k) 1
#endif
#ifdef DELAY_PHASE
#define PH_T0(k) const unsigned long long _pt0_##k = ((k) == DELAY_PHASE) ? rt_v() : 0ull
#define PH_T1(k) do { if ((k) == DELAY_PHASE) { const unsigned long long _t1 = rt_v(); while (rt_v() < _t1 + (_t1 - _pt0_##k)) __builtin_amdgcn_s_sleep(8); } } while (0)
#else
#define PH_T0(k)
#define PH_T1(k)
#endif
    unsigned* barw = (unsigned*)(ws + WS_BAR);
    volatile LAS unsigned* bst = (volatile LAS unsigned*)(lds + LDS_MISC);
    if (wave == 0) { if (lane_id_v() == 0) { bst[0] = 0u; bst[1] = 0u; } }
#define GBAR() grid_bar(barw, bst, (unsigned)G, wave)
#define GSYNC0() do { grid.sync(); if (wave == 0) { if (lane_id_v() == 0) (void)xb_add(&barw[XB_XCNT(xb_xcc_id())], 1u); } } while (0)
#if defined(DELAY_PHASE) && DELAY_PHASE == 8
#define SEAM(k) do { if (IN(k) && IN((k) + 1)) { const unsigned long long _b0 = rt_v(); if ((k) == 0) GSYNC0(); else GBAR(); const unsigned long long _b1 = rt_v(); while (rt_v() < _b1 + (_b1 - _b0)) __builtin_amdgcn_s_sleep(8); } } while (0)
#elif defined(DOUBLE_BAR)
#define SEAM(k) do { if (IN(k) && IN((k) + 1)) { if ((k) == 0) GSYNC0(); else GBAR(); GBAR(); } } while (0)
#else
#define SEAM(k) do { if (IN(k) && IN((k) + 1)) { if ((k) == 0) GSYNC0(); else GBAR(); } } while (0)
#endif

    PH_T0(0);
    for (int rep = 0; rep < REP(0); ++rep) if (IN(0)) {
        const int lane = lane_id_v(), tid = wave * 64 + lane;
        LAS float* scr = (LAS float*)(lds + wave * 16384);
        const int gw = wave * G + vcu, NGW = G * NWAVES;
        if (bx == 0) { for (int i = tid; i < 1024; i += 512) ((unsigned*)(ws + WS_R1 - 4096))[i] = 0u; for (int i = tid; i < 4160 + 64 * 64; i += 512) __hip_atomic_store(barw + i, (i == 4096) ? 0x7fffffffu : 0u, __ATOMIC_RELAXED, __HIP_MEMORY_SCOPE_AGENT);
            if (false) __hip_atomic_store(barw + 4096, 0x7fffffffu, __ATOMIC_RELAXED, __HIP_MEMORY_SCOPE_AGENT); }
        constexpr int I_MKV = 128, I_WP = 512;
        constexpr int I_IN = 16 * 160, I_UA = 8 * 32, I_UM = 4 * 32, I_WO = 16 * 32, I_FU = 16 * 176, I_FD = 44 * 32;
        constexpr int I_ROWS = S / 2;
        constexpr int NITEMS = I_WP + I_IN + I_UA + I_UM + I_WO + I_FU + I_FD + I_ROWS;
        if (vcu < I_MKV) {
            const int nb = vcu >> 3, mb = vcu & 7, rr = lane & 31, gg = lane >> 5; const int n0 = 32 * nb, m0 = 32 * mb;
            f32x16 acc; for (int i = 0; i < 16; ++i) acc[i] = 0.f;
            float ss = 0.f;
            const float* mrow = mem + (size_t)(m0 + rr) * D;
#pragma unroll 8
            for (int k0 = 128 * wave; k0 < 128 * wave + 128; k0 += 16) { const int kk = k0 + 8 * gg;
                const f32x4 a0 = *(const f32x4*)(mrow + kk), a1 = *(const f32x4*)(mrow + kk + 4), g0 = *(const f32x4*)(g_mem + kk), g1 = *(const f32x4*)(g_mem + kk + 4);
                ss += (a0[0] * a0[0] + a0[1] * a0[1]) + (a0[2] * a0[2] + a0[3] * a0[3]) + (a1[0] * a1[0] + a1[1] * a1[1]) + (a1[2] * a1[2] + a1[3] * a1[3]);
                const bf16x8 bfr = __builtin_bit_cast(bf16x8, pack8(a0 * g0, a1 * g1));
                float wv[8];
#pragma unroll
                for (int j = 0; j < 8; ++j) wv[j] = w_mem_kv[(size_t)(kk + j) * 512 + n0 + rr];
                u32x4 wa; wa.x = pk2(wv[0], wv[1]); wa.y = pk2(wv[2], wv[3]); wa.z = pk2(wv[4], wv[5]); wa.w = pk2(wv[6], wv[7]);
                acc = MFMA32(__builtin_bit_cast(bf16x8, wa), bfr, acc); }
#pragma unroll
            for (int i = 0; i < 16; ++i) scr[i * 64 + lane] = acc[i];
            scr[1024 + lane] = ss;
            __syncthreads();
            if (wave == 0) {
#pragma unroll
                for (int w = 1; w < 8; ++w) { const LAS float* pw = (const LAS float*)(lds + w * 16384);
#pragma unroll
                    for (int i = 0; i < 16; ++i) acc[i] += pw[i * 64 + lane];
                    ss += pw[1024 + lane]; }
                ss += __shfl_xor(ss, 32);
                const float rstd = __builtin_amdgcn_rsqf(ss * (1.f / D) + EPS);
                const int mI = m0 + rr;
                if (n0 < 256) {
#pragma unroll
                    for (int ig = 0; ig < 4; ++ig) { u32x2 w; w.x = pk2(acc[4 * ig] * rstd, acc[4 * ig + 1] * rstd); w.y = pk2(acc[4 * ig + 2] * rstd, acc[4 * ig + 3] * rstd);
                        *(u32x2*)(KM + kf_elem(8, n0 >> 6, mI, (n0 & 63) + 8 * ig + 4 * gg)) = w; }
                } else {
#pragma unroll
                    for (int i = 0; i < 16; ++i) { const int nn = n0 - 256 + crow(i, gg); VMT[vf_elem(8, nn >> 6, mI, nn & 63)] = (bf16_t)(pk2(acc[i] * rstd, 0.f) & 0xffffu); }
                }
            }
            __syncthreads();
        }
        for (int it = gw; it < NITEMS; it += NGW) {
            int r = it;
            if (r < I_WP) {
                const int gI = r >> 7, c0 = ((r >> 4) & 7) * 8, n = (r & 15) * 64 + lane;
                float a[8]; for (int i = 0; i < 8; ++i) a[i] = 0.f;
#pragma unroll 64
                for (int d = 0; d < 64; ++d) { const float wv = w_up_pool[(size_t)(gI * 64 + d) * D + n] * pool_scale[gI * 64 + d];
#pragma unroll
                    for (int ci = 0; ci < 8; ++ci) a[ci] += w_pool[(size_t)((gI * 64 + c0 + ci) * 64) + d] * wv; }
                u32x4 w; w.x = pk2(a[0], a[1]); w.y = pk2(a[2], a[3]); w.z = pk2(a[4], a[5]); w.w = pk2(a[6], a[7]);
                *(u32x4*)(WUP + (size_t)n * D + gI * 64 + c0) = w;
                continue; } r -= I_WP;
            if (r < I_IN + I_UA + I_UM + I_WO + I_FU + I_FD) {
                const float* W; int N, ldt = D, koff = 0, ro = 0, kb, nb; bf16_t* WT; const float* ks = nullptr;
                if (r < I_IN) { kb = r / 160; nb = r % 160; const int n0 = 32 * nb;
                    ro = (n0 < 1280) ? 0 : (n0 < 1792) ? (4608 - 1280) : -512; W = w_in; N = NIN; WT = WIN; }
                else if ((r -= I_IN) < I_UA) { kb = r / 32; nb = r % 32; W = w_up_attn; N = D; WT = WUP; koff = 256; }
                else if ((r -= I_UA) < I_UM) { kb = r / 32; nb = r % 32; W = w_up_mem; N = D; WT = WUP; koff = 768; }
                else if ((r -= I_UM) < I_WO) { kb = r / 32; nb = r % 32; W = w_out; N = D; WT = WOUT; }
                else if ((r -= I_WO) < I_FU) { kb = r / 176; nb = r % 176; W = w_ffn_up; N = 2 * DFF; WT = WFUP; ks = g_ffn; }
                else { r -= I_FU; kb = r / 32; nb = r % 32; W = w_ffn_down; N = D; WT = WDN; ldt = DFF; }
                transpose_item(W, N, WT, ldt, koff, ro, ks, scr, kb, nb, lane); continue; }
            r -= I_IN + I_UA + I_UM + I_WO + I_FU + I_FD;
            {
                const f32x4* xr = (const f32x4*)(x + (size_t)(2 * r) * D) + lane; const f32x4* gr = (const f32x4*)g_mix + lane;
                f32x4 v[8]; float s0 = 0.f, s1 = 0.f;
#pragma unroll
                for (int j = 0; j < 8; ++j) v[j] = xr[64 * j];
#pragma unroll
                for (int j = 0; j < 4; ++j) { s0 += (v[j][0] * v[j][0] + v[j][1] * v[j][1]) + (v[j][2] * v[j][2] + v[j][3] * v[j][3]);
                    s1 += (v[4 + j][0] * v[4 + j][0] + v[4 + j][1] * v[4 + j][1]) + (v[4 + j][2] * v[4 + j][2] + v[4 + j][3] * v[4 + j][3]); }
                const float rstd0 = __builtin_amdgcn_rsqf(wave_sum(s0) * (1.f / D) + EPS), rstd1 = __builtin_amdgcn_rsqf(wave_sum(s1) * (1.f / D) + EPS);
                u32x2* o8 = (u32x2*)(R1 + (size_t)(2 * r) * D) + lane;
#pragma unroll
                for (int j = 0; j < 8; ++j) { const f32x4 gg = gr[64 * (j & 3)]; const float rs = (j < 4) ? rstd0 : rstd1;
                    u32x2 w; w.x = pk2(v[j][0] * rs * gg[0], v[j][1] * rs * gg[1]); w.y = pk2(v[j][2] * rs * gg[2], v[j][3] * rs * gg[3]); o8[64 * j] = w; }
            }
        }
    }
    PH_T1(0);
    SEAM(0);
#ifdef DIAG
    unsigned* dg = (unsigned*)(ws + WS_BAR + 16384);
    if (bx == 0) { const int tid = wave * 64 + lane_id_v(); const unsigned h = hsh(tid * 7 + 1);
        { const int n = h % NIN, k = (h >> 13) % D; const int np = (n < 1280) ? n : (n < 1792) ? n + 3328 : n - 512; DCHK(11, bfv(WIN + (size_t)np * D + k), w_in[(size_t)k * NIN + n], 0.01f, 1e-4f); }
        { const int n = h % D, k = (h >> 13) % 512; DCHK(12, bfv(WUP + (size_t)n * D + 256 + k), w_up_attn[(size_t)k * D + n], 0.01f, 1e-4f); }
        { const int n = h % D, k = (h >> 13) % 256; DCHK(13, bfv(WUP + (size_t)n * D + 768 + k), w_up_mem[(size_t)k * D + n], 0.01f, 1e-4f); }
        { const int n = h % D, gc = (h >> 13) % 256, gI = gc >> 6; float e = 0.f; for (int d = 0; d < 64; ++d) e += w_pool[(size_t)gc * 64 + d] * pool_scale[gI * 64 + d] * w_up_pool[(size_t)(gI * 64 + d) * D + n];
          DCHK(14, bfv(WUP + (size_t)n * D + gc), e, 0.01f, 1e-3f); }
        { const int n = h % D, k = (h >> 13) % D; DCHK(15, bfv(WOUT + (size_t)n * D + k), w_out[(size_t)k * D + n], 0.01f, 1e-4f); }
        { const int n = h % (2 * DFF), k = (h >> 13) % D; DCHK(16, bfv(WFUP + (size_t)n * D + k), w_ffn_up[(size_t)k * 2 * DFF + n] * g_ffn[k], 0.01f, 1e-4f); }
        { const int n = h % D, k = (h >> 13) % DFF; DCHK(17, bfv(WDN + (size_t)n * DFF + k), w_ffn_down[(size_t)k * D + n], 0.01f, 1e-4f); }
        { const int m = h % 256, n = (h >> 13) % 512; float ss = 0.f, e = 0.f; for (int k = 0; k < D; ++k) { const float a = mem[(size_t)m * D + k]; ss += a * a; e += a * g_mem[k] * w_mem_kv[(size_t)k * 512 + n]; }
          e *= 1.f / sqrtf(ss / D + EPS); const float got = (n < 256) ? bfv(KM + kf_elem(8, n >> 6, m, n & 63)) : bfv(VMT + vf_elem(8, (n - 256) >> 6, m, (n - 256) & 63)); DCHK(18, got, e, 0.02f, 5e-3f); }
        { const int r = srow(tid), c = (h >> 7) % D; float ss = 0.f; for (int k = 0; k < D; ++k) { const float a = x[(size_t)r * D + k]; ss += a * a; }
          DCHK(19, bfv(R1 + (size_t)r * D + c), x[(size_t)r * D + c] / sqrtf(ss / D + EPS) * g_mix[c], 0.01f, 1e-3f); }
        if (tid < 1024) DCHK(10, bfv(R1 - 2 * D + tid) + bfv(R1 - 2 * D + tid + 512) + bfv(R1 - 2 * D + tid + 1024) + bfv(R1 - 2 * D + tid + 1536), 0.f, 0.f, 0.f);
    }
    GBAR();
#endif
    PH_T0(1);
    for (int rep = 0; rep < REP(1); ++rep) if (IN(1)) {
        { pg8::Gemm g{R1, WIN, D, (size_t)256 * D * 2, (size_t)128 * D * 2, (size_t)256 * D * 2, (size_t)128 * D * 2};
          pg8::StaticOrder So; So.init(S / 256, 18, G, bx); EpiIn E{QKU, GATES, b_gate, KFb};
          pg8::gemm_phase<EpiIn, pg8::StaticOrder>(lds, g, So, E, wave); }
        { pg8::Gemm g{WIN + (size_t)4608 * D, R1, D, (size_t)256 * D * 2, (size_t)128 * D * 2, (size_t)256 * D * 2, (size_t)128 * D * 2};
          pg8::StaticOrder So; So.init(2, S / 256, G, (bx + G / 2) % G); EpiVT E{VTb};
          pg8::gemm_phase<EpiVT, pg8::StaticOrder>(lds, g, So, E, wave); }
    }
    PH_T1(1);
    SEAM(1);
#ifdef DIAG
    if (bx == 0) { const int tid = wave * 64 + lane_id_v(); const unsigned h = hsh(tid * 11 + 3); const int r = srow(tid);
        { const int c = h % 4608; float e = dotbb(R1 + (size_t)r * D, WIN + (size_t)c * D, D);
          if (c < 1536) { if ((c >= 256 && c < 768) || c >= 1280) e *= QSCALE; const float got = (c >= 768 && c < 1280) ? bfv(KFb + kf_elem(512, (c - 768) >> 6, r, (c - 768) & 63)) : bfv(QKU + (size_t)r * QKU_P + c); DCHK(21 + (c >= 256) + (c >= 768) + (c >= 1280), got, e, 0.02f, 0.02f); }
          else { e = 1.f / (1.f + expf(-(e + b_gate[c - 1536]))); DCHK(25, bfv(GATES + (size_t)r * GATE_P + c - 1536), e, 0.02f, 0.01f); } }
        { const int c = h % 512; const float e = dotbb(R1 + (size_t)r * D, WIN + (size_t)(4608 + c) * D, D); DCHK(26, bfv(VTb + vf_elem(512, c >> 6, r, c & 63)), e, 0.02f, 0.02f); }
    }
    GBAR();
#endif
    PH_T0(2);
    for (int rep = 0; rep < REP(2); ++rep) if (IN(2)) {
        const int lane = lane_id_v(), tid = wave * 64 + lane;
        LAS float* bl = (LAS float*)(lds + LDS_BIAS);
        for (int i = tid; i < 8 * 321; i += 512) { const int hh = i / 321, j = i % 321; bl[i] = rel_bias[hh * 257 + (j > 256 ? 256 : j)] * LOG2E; }
        __syncthreads();
        bf16_t* OCAT = R1;
        for (int c = vcu; c < S / 64; c += G) {
            { const int jtmin = (c >= 8) ? 0 : 8 - c; const int tok0 = 64 * (c - 8 + jtmin);
              attn_wave(QKU + (size_t)64 * c * QKU_P + 256 + 64 * wave, QKU_P, KFb + kf_elem(512, wave, tok0, 0), VTb + vf_elem(512, wave, tok0, 0),
                        2 * (9 - jtmin), jtmin, bl + wave * 321, true, OCAT + (size_t)64 * c * D + 256 + 64 * wave, D, lane, lds + wave * 8192); }
            if (wave < 4) {
                attn_wave(QKU + (size_t)64 * c * QKU_P + 1280 + 64 * wave, QKU_P, KM + kf_elem(8, wave, 0, 0), VMT + vf_elem(8, wave, 0, 0), 8, 0,
                          bl, false, OCAT + (size_t)64 * c * D + 768 + 64 * wave, D, lane, lds + wave * 8192);
            } else {
                const int gI = wave - 4, ch = gI * 64 + (lane & 7) * 8, t0 = 64 * c + (lane >> 3) * 8;
                const bf16_t* U = QKU + ch; bf16_t* OC = OCAT + ch;
                if (gI == 0) pool_lane<2>(U, OC, t0); else if (gI == 1) pool_lane<4>(U, OC, t0); else if (gI == 2) pool_lane<8>(U, OC, t0); else pool_lane<16>(U, OC, t0);
            }
        }
    }
    PH_T1(2);
    SEAM(2);
#ifdef DIAG
    if (bx == 0) { const int tid = wave * 64 + lane_id_v(); const unsigned h = hsh(tid * 13 + 5); const int t = srow(tid);
        { const int ch = h % 256, gI = ch >> 6, win = 2 << gI; float sm = 0.f; for (int i = 0; i < win; ++i) if (t - i >= 0) sm += bfv(QKU + (size_t)(t - i) * QKU_P + ch);
          const float e = sm / (float)((t + 1 < win) ? t + 1 : win) - bfv(QKU + (size_t)t * QKU_P + ch); DCHK(31, bfv(R1 + (size_t)t * D + ch), e, 0.02f, 0.02f); }
        { const int hh = (h >> 8) % 8, d = (h >> 12) % 64, c = t >> 6; float mx = -1e30f, den = 0.f, num = 0.f;
          for (int pass = 0; pass < 2; ++pass) for (int j = 0; j < 576; ++j) { const int kt = 64 * (c - 8) + j; if (kt < 0) continue;
              float sc = 0.f; for (int dd = 0; dd < 64; ++dd) sc += bfv(QKU + (size_t)t * QKU_P + 256 + 64 * hh + dd) * bfv(KFb + kf_elem(512, hh, kt, dd));
              int rel = t - kt; rel = rel > 128 ? 128 : (rel < -128 ? -128 : rel); sc += rel_bias[hh * 257 + rel + 128] * LOG2E;
              if (pass == 0) mx = fmaxf(mx, sc); else { const float p = exp2f(sc - mx); den += p; num += p * bfv(VTb + vf_elem(512, hh, kt, d)); } }
          DCHK(32, bfv(R1 + (size_t)t * D + 256 + 64 * hh + d), num / den, 0.03f, 0.01f); }
        { const int hh = (h >> 8) % 4, d = (h >> 12) % 64; float mx = -1e30f, den = 0.f, num = 0.f;
          for (int pass = 0; pass < 2; ++pass) for (int j = 0; j < 256; ++j) { float sc = 0.f; for (int dd = 0; dd < 64; ++dd) sc += bfv(QKU + (size_t)t * QKU_P + 1280 + 64 * hh + dd) * bfv(KM + kf_elem(8, hh, j, dd));
              if (pass == 0) mx = fmaxf(mx, sc); else { const float p = exp2f(sc - mx); den += p; num += p * bfv(VMT + vf_elem(8, hh, j, d)); } }
          DCHK(33, bfv(R1 + (size_t)t * D + 768 + 64 * hh + d), num / den, 0.03f, 0.01f); }
    }
    GBAR();
#endif
    PH_T0(3);
    for (int rep = 0; rep < REP(3); ++rep) if (IN(3)) {
        pg8::Gemm g{R1, WUP, D, (size_t)256 * D * 2, (size_t)128 * D * 2, (size_t)256 * D * 2, (size_t)128 * D * 2};
        pg8::StaticOrder So; So.init(S / 256, 4, G, bx); EpiMerge E{GATES, MERGED};
        pg8::gemm_phase<EpiMerge, pg8::StaticOrder>(lds, g, So, E, wave);
    }
    PH_T1(3);
    SEAM(3);
#ifdef DIAG
    if (bx == 0) { const int tid = wave * 64 + lane_id_v(); const unsigned h = hsh(tid * 17 + 7); const int r = srow(tid), c = h % D;
        const float y0 = dotbb(R1 + (size_t)r * D, WUP + (size_t)c * D, 256), y1 = dotbb(R1 + (size_t)r * D + 256, WUP + (size_t)c * D + 256, 512), y2 = dotbb(R1 + (size_t)r * D + 768, WUP + (size_t)c * D + 768, 256);
        const float e = bfv(GATES + (size_t)r * GATE_P + c) * y0 + bfv(GATES + (size_t)r * GATE_P + D + c) * y1 + bfv(GATES + (size_t)r * GATE_P + 2 * D + c) * y2;
        DCHK(41, bfv(MERGED + (size_t)r * D + c), e, 0.03f, 0.02f); }
    GBAR();
#endif
    PH_T0(4);
    for (int rep = 0; rep < REP(4); ++rep) if (IN(4)) {
        pg8::Gemm g{MERGED, WOUT, D, (size_t)256 * D * 2, (size_t)128 * D * 2, (size_t)256 * D * 2, (size_t)128 * D * 2};
        pg8::StaticOrder So; So.init(S / 256, 4, G, bx); EpiResid<false> E{x, R1, PART};
        pg8::gemm_phase<EpiResid<false>, pg8::StaticOrder>(lds, g, So, E, wave);
    }
    PH_T1(4);
    SEAM(4);
#ifdef DIAG
    if (bx == 0) { const int tid = wave * 64 + lane_id_v(); const unsigned h = hsh(tid * 19 + 9); const int r = srow(tid), c = h % D;
        const float e = x[(size_t)r * D + c] + dotbb(MERGED + (size_t)r * D, WOUT + (size_t)c * D, D);
        DCHK(52, bfv(R1 + (size_t)r * D + c), e, 0.02f, 0.02f);
        float ss = 0.f, ps = 0.f; for (int k = 0; k < D; ++k) { const float a = bfv(R1 + (size_t)r * D + k); ss += a * a; } for (int k = 0; k < 16; ++k) ps += PART[(size_t)r * 16 + k];
        DCHK(53, ps, ss, 0.01f, 0.f); }
    GBAR();
#endif
    PH_T0(5);
    for (int rep = 0; rep < REP(5); ++rep) if (IN(5)) {
        pg8::Gemm g{R1 - 2 * D, WFUP, D, (size_t)252 * D * 2, (size_t)4 * D * 2, (size_t)128 * D * 2, (size_t)DFF * D * 2};
        pg8::StaticOrder So; So.init(66, 22, G, bx);
        LAS float* RS = (LAS float*)(lds + LDS_BIAS);
        { const int tid5 = wave * 64 + lane_id_v(), slot = tid5 & 255; Unit uu;
          for (int i = tid5 >> 8; i < 8 && So.next(i, uu); i += 2) { const int row = 252 * uu.pm - 2 + 126 * (slot >> 7) + (slot & 127); float v = 0.f;
              if (row >= 0 && row < S) { const f32x4* p = (const f32x4*)(PART + (size_t)row * 16); const f32x4 t = (p[0] + p[1]) + (p[2] + p[3]);
                  v = __builtin_amdgcn_rsqf(((t[0] + t[1]) + (t[2] + t[3])) * (1.f / D) + EPS); }
              RS[i * 256 + slot] = v; }
          __syncthreads(); }
        EpiFfnUp E{ACT, RS, conv_w, conv_b, (bf16_t*)(ws + WS_DUMP)};
        pg8::gemm_phase<EpiFfnUp, pg8::StaticOrder>(lds, g, So, E, wave);
    }
    PH_T1(5);
    SEAM(5);
#ifdef DIAG
    if (bx == 0) { const int tid = wave * 64 + lane_id_v(); const unsigned h = hsh(tid * 23 + 11); const int t = srow(tid), j = h % DFF;
        float cg = conv_b[j], cv = conv_b[DFF + j];
        for (int k = 0; k < 3; ++k) { const int tt = t - 2 + k; if (tt < 0) continue; float ps = 0.f; for (int q = 0; q < 16; ++q) ps += PART[(size_t)tt * 16 + q];
            const float rstd = 1.f / sqrtf(ps / D + EPS);
            cg += conv_w[(size_t)k * 2 * DFF + j] * rstd * dotbb(R1 + (size_t)tt * D, WFUP + (size_t)j * D, D);
            cv += conv_w[(size_t)k * 2 * DFF + DFF + j] * rstd * dotbb(R1 + (size_t)tt * D, WFUP + (size_t)(DFF + j) * D, D); }
        const float e = 0.5f * cg * (1.f + erff(cg * 0.70710678f)) * cv;
        DCHK(61 + ((tid < 64) ? (tid & 7) : 8), bfv(ACT + (size_t)t * DFF + j), e, 0.03f, 0.03f); }
    GBAR();
#endif
    PH_T0(6);
    const bool fuse_final = (G == 256);
    if (IN(6)) {
        pg8::Gemm g{ACT, WDN, DFF, (size_t)256 * DFF * 2, (size_t)128 * DFF * 2, (size_t)256 * DFF * 2, (size_t)128 * DFF * 2};
        pg8::StaticOrder So; So.init(S / 256, 4, G, bx);
        if (fuse_final) { EpiFinal E{R1, out, PART2, barw + 4160, g_final, barw + XB_TMO};
            pg8::gemm_phase<EpiFinal, pg8::StaticOrder>(lds, g, So, E, wave); }
        else { EpiResid<true> E{nullptr, R1, PART2};
            pg8::gemm_phase<EpiResid<true>, pg8::StaticOrder>(lds, g, So, E, wave); }
    }
    PH_T1(6);
    if (!fuse_final) SEAM(6);
    PH_T0(7);
    if (IN(7) && !fuse_final) {
        const int lane = lane_id_v();
        const int gw = vcu * NWAVES + wave, NGW = G * NWAVES;
        for (int r = gw; r < S; r += NGW) {
            const f32x4* p = (const f32x4*)(PART2 + (size_t)r * 16); const f32x4 t = (p[0] + p[1]) + (p[2] + p[3]);
            const float rstd = __builtin_amdgcn_rsqf(((t[0] + t[1]) + (t[2] + t[3])) * (1.f / D) + EPS);
            const u32x2* xr = (const u32x2*)(R1 + (size_t)r * D) + lane; const f32x4* gr = (const f32x4*)g_final + lane;
            f32x4* xw = (f32x4*)(out + (size_t)r * D) + lane;
#pragma unroll
            for (int j = 0; j < 4; ++j) { const u32x2 a = xr[64 * j]; const f32x4 v = {bflo(a.x), bfhi(a.x), bflo(a.y), bfhi(a.y)}; xw[64 * j] = v * gr[64 * j] * rstd; }
        }
    }
    PH_T1(7);
#ifdef DIAG
    GBAR();
    if (bx == 0 && wave == 0 && lane_id_v() == 0) { const unsigned code = __hip_atomic_load(dg, __ATOMIC_RELAXED, __HIP_MEMORY_SCOPE_AGENT); if (code != 0x7fffffffu) out[0] = 100.f * (float)code; }
#endif
#undef IN
#undef SEAM
}

#ifndef N_LAUNCHES
#define N_LAUNCHES 1
#endif
extern "C" void kernel_launch(void* const* d_in, const int* in_sizes, int n_in, void* d_out, int out_size, void* d_ws, size_t ws_size, hipStream_t stream) {
    static int grid = 0;
    if (grid == 0) {
        if (n_in != 20 || out_size != S * D || ws_size < WS_END) { fprintf(stderr, "kernel_launch: unexpected shapes (n_in %d out %d ws %zu)\n", n_in, out_size, ws_size); grid = -1; return; }
        int dev = 0, cus = 0, per_cu = 0;
        hipGetDevice(&dev); hipDeviceGetAttribute(&cus, hipDeviceAttributeMultiprocessorCount, dev);
        if (hipFuncSetAttribute((const void*)fwd_kernel, hipFuncAttributeMaxDynamicSharedMemorySize, LDS_BYTES) != hipSuccess) { fprintf(stderr, "kernel_launch: hipFuncSetAttribute failed\n"); grid = -1; return; }
        if (hipOccupancyMaxActiveBlocksPerMultiprocessor(&per_cu, (const void*)fwd_kernel, NWAVES * 64, LDS_BYTES) != hipSuccess || per_cu < 1) per_cu = 1;
        (void)hipGetLastError();
        grid = cus * per_cu; if (grid > 256) grid = 256;
        fprintf(stderr, "kernel_launch: grid %d (cus %d per_cu %d)\n", grid, cus, per_cu);
    }
    if (grid < 0) return;
    Args a{};
    for (int i = 0; i < 20; ++i) a.in[i] = (const float*)d_in[i];
    a.out = (float*)d_out; a.ws = (unsigned char*)d_ws;
#if N_LAUNCHES == 1
    a.ph_lo = 0; a.ph_hi = 8;
    void* kargs[] = {&a};
    hipError_t e = hipLaunchCooperativeKernel((const void*)fwd_kernel, dim3(grid), dim3(NWAVES * 64), kargs, LDS_BYTES, stream);
    if (e != hipSuccess) fprintf(stderr, "cooperative launch failed: %s (grid %d)\n", hipGetErrorString(e), grid);
#else
    for (int p = 0; p < 8; ++p) { a.ph_lo = p; a.ph_hi = p + 1; hipLaunchKernelGGL(fwd_kernel, dim3(grid), dim3(NWAVES * 64), LDS_BYTES, stream, a); }
#endif
}
```

```cpp
#include <hip/hip_runtime.h>
#include <hip/hip_cooperative_groups.h>
#include <cstdio>
#include <cstdint>
namespace cg = cooperative_groups;

#define DI __device__ __forceinline__
#define LAS __attribute__((address_space(3)))
typedef unsigned short bf16_t;
typedef short bf16x8 __attribute__((ext_vector_type(8)));
typedef short s16x4 __attribute__((ext_vector_type(4)));
typedef float f32x2 __attribute__((ext_vector_type(2)));
typedef float f32x4 __attribute__((ext_vector_type(4)));
typedef float f32x16 __attribute__((ext_vector_type(16)));
typedef unsigned u32x2 __attribute__((ext_vector_type(2)));
typedef unsigned u32x4 __attribute__((ext_vector_type(4)));
typedef __bf16 bf16x2_t __attribute__((ext_vector_type(2)));

constexpr int S = 16384, D = 1024, DFF = 2816, NIN = 5120, NWAVES = 8;
constexpr float EPS = 1e-6f, LOG2E = 1.4426950408889634f, QSCALE = 0.125f * LOG2E;
constexpr int QKU_P = 1536, GATE_P = 3072;
constexpr size_t MiB = 1u << 20;
constexpr size_t WS_WIN = 0, WS_WUP = 10 * MiB, WS_WOUT = 12 * MiB, WS_WFUP = 14 * MiB, WS_WDN = 25 * MiB;
constexpr size_t WS_KM = 31 * MiB, WS_VMT = WS_KM + 131072, WS_PART = WS_VMT + 131072, WS_PART2 = WS_PART + MiB;
constexpr size_t WS_BAR = WS_PART2 + MiB;
constexpr size_t WS_R1 = 34 * MiB;
constexpr size_t WS_QKU = 67 * MiB, WS_GATES = 115 * MiB, WS_VT = 211 * MiB, WS_KF = 227 * MiB, WS_END = 245 * MiB;
constexpr size_t WS_MERGED = WS_QKU, WS_ACT = WS_QKU, WS_DUMP = 244 * MiB;
constexpr int LDS_RING = 131072, LDS_BIAS = LDS_RING, LDS_MISC = LDS_BIAS + 10496, LDS_BYTES = 147456;

DI unsigned pk2(float lo, float hi) { f32x2 v = {lo, hi}; bf16x2_t b = __builtin_convertvector(v, bf16x2_t); return __builtin_bit_cast(unsigned, b); }
DI float bflo(unsigned u) { return __builtin_bit_cast(float, u << 16); }
DI float bfhi(unsigned u) { return __builtin_bit_cast(float, u & 0xffff0000u); }
DI float wave_sum(float v) {
#pragma unroll
    for (int o = 1; o < 64; o <<= 1) v += __shfl_xor(v, o);
    return v;
}
DI unsigned long long rt_v() { unsigned long long t; asm volatile("s_memrealtime %0\n\ts_waitcnt lgkmcnt(0)" : "=s"(t) :: "memory"); return t; }
DI int lane_id_v() { int l; asm volatile("v_mbcnt_lo_u32_b32 %0, -1, 0\n\tv_mbcnt_hi_u32_b32 %0, -1, %0" : "=v"(l)); return l; }
DI float dpp_shr1(float v) { float r; asm volatile("s_nop 1\n\tv_mov_b32_dpp %0, %1 row_shr:1 row_mask:0xf bank_mask:0xf bound_ctrl:1\n\ts_nop 1" : "=&v"(r) : "v"(v)); return r; }
DI void half_swap(float& a, float& b) { asm volatile("s_nop 1\n\tv_permlane32_swap_b32 %0, %1\n\ts_nop 1" : "+v"(a), "+v"(b)); }
DI float xhalf_max(float m) { float a = m, b = m; half_swap(a, b); return fmaxf(a, b); }
DI float xhalf_sum(float m) { float a = m, b = m; half_swap(a, b); return a + b; }
DI f32x2 gelu_pk(f32x2 v) {
    const f32x2 av = __builtin_elementwise_abs(v), d = av * 0.2316418882f + 1.0f;
    f32x2 t; t.x = __builtin_amdgcn_rcpf(d.x); t.y = __builtin_amdgcn_rcpf(d.y);
    f32x2 q = t * 0.5307027145f + (-0.7265760135f); q = q * t + 0.7107068705f; q = q * t + (-0.142248368f); q = q * t + 0.127414796f; q = q * t;
    const f32x2 s = (v * v) * (-0.72134752044f);
    f32x2 e; e.x = __builtin_amdgcn_exp2f(s.x); e.y = __builtin_amdgcn_exp2f(s.y);
    const f32x2 m = v * (q * e), r = v - m;
    f32x2 o; o.x = v.x < 0.f ? m.x : r.x; o.y = v.y < 0.f ? m.y : r.y; return o;
}

namespace pg8 {
constexpr int BM = 256, BK = 64, HALF = 128, HTB = HALF * BK * 2, NXCD = 8, WGM = 8;
DI int lds_byte(int r, int c) { const int st = (r >> 4) * 2 + (c >> 5), rr = r & 15, cc = c & 31, ob = rr * 64 + cc * 2; return st * 1024 + (ob ^ (((ob >> 9) & 1) << 5)); }
DI void stage_rc(int b, int& R, int& C) { const int st = b / 1024, sb = b % 1024, swz = sb ^ (((sb >> 9) & 1) << 5); R = (st >> 1) * 16 + swz / 64; C = (st & 1) * 32 + (swz % 64) / 2; }
DI int perm32(int rho) { const int n = rho >> 4, i = rho & 15; return 8 * (i >> 2) + 4 * n + (i & 3); }
struct Unit { int pm, pn, idx; };
struct Gemm { const bf16_t* A; const bf16_t* Bt; int K; size_t a_tstep, a_hstep, b_tstep, b_hstep; };
struct StaticOrder {
    int nM, nN, nwg, G, c;
    DI void init(int nM_, int nN_, int G_, int c_) { nM = nM_; nN = nN_; nwg = nM * nN; G = G_; c = c_; }
    DI bool next(int i, Unit& u) const {
        const long L = (long)i * G + c; if (L >= nwg) return false;
        int wgid = (int)L; { const int q = nwg / NXCD, r = nwg % NXCD, xcd = wgid % NXCD, off = wgid / NXCD; wgid = (xcd < r ? xcd * (q + 1) : r * (q + 1) + (xcd - r) * q) + off; }
        const int nig = WGM * nN, gid = wgid / nig, fm = gid * WGM, gsz = (nM - fm) < WGM ? (nM - fm) : WGM;
        u.pm = fm + ((wgid % nig) % gsz); u.pn = (wgid % nig) / gsz; u.idx = i; return true;
    }
};
template <class Epi, class Sched>
DI void gemm_phase(LAS unsigned char* lds, const Gemm g, const Sched& S, const Epi& E, const int wid) {
    const int lane = lane_id_v();
    const int tid = wid * 64 + lane, wr = wid >> 2, wc = wid & 3, fr = lane & 15, fq = lane >> 4;
    const int K = g.K, nt = K / BK;
    unsigned voffA[2], voffB[2];
#pragma unroll
    for (int i = 0; i < 2; ++i) { int R, C; stage_rc(tid * 16 + i * 8192, R, C); const int Rb = (R & ~31) + perm32(R & 31);
        const int Ra = Epi::ROWPERM ? (126 * (R >> 6) + 8 * (R & 15) + ((R >> 4) & 3)) : R;
        voffA[i] = (unsigned)(Ra * K + C) * 2u; voffB[i] = (unsigned)(Rb * K + C) * 2u; }
    const size_t kstep = (size_t)(BK * 2);
    const size_t hstepA = g.a_hstep, hstepB = g.b_hstep;
    const unsigned ldsw = (unsigned)wid * 1024u;
    const int aoff = lds_byte(wr * 64 + fr, fq * 8), boff = lds_byte(wc * 32 + fr, fq * 8);
#define PG8_SA(b, h) (((b) * 2 + (h)) * HTB)
#define PG8_SB(b, h) ((4 + (b) * 2 + (h)) * HTB)
#define PG8_STAGE(bufoff, gbase, voff) do { _Pragma("unroll") for (int _i = 0; _i < 2; ++_i) \
        __builtin_amdgcn_global_load_lds((const unsigned*)((const char*)(gbase) + (voff)[_i]), (LAS unsigned*)(lds + (bufoff) + ldsw + _i * 8192), 16, 0, 0); } while (0)
#define PG8_LDA(dst, b, h) do { _Pragma("unroll") for (int m = 0; m < 4; ++m) _Pragma("unroll") for (int k = 0; k < 2; ++k) dst[m][k] = *(const LAS bf16x8*)(lds + PG8_SA(b, h) + aoff + m * 2048 + k * 1024); } while (0)
#define PG8_LDB(dst, b, h) do { _Pragma("unroll") for (int n = 0; n < 2; ++n) _Pragma("unroll") for (int k = 0; k < 2; ++k) dst[n][k] = *(const LAS bf16x8*)(lds + PG8_SB(b, h) + boff + n * 2048 + k * 1024); } while (0)
#define PG8_MMA(ai, bj, At, Bt) do { __builtin_amdgcn_s_setprio(1); _Pragma("unroll") for (int m = 0; m < 4; ++m) _Pragma("unroll") for (int n = 0; n < 2; ++n) _Pragma("unroll") for (int k = 0; k < 2; ++k) \
        acc[ai][bj][m][n] = __builtin_amdgcn_mfma_f32_16x16x32_bf16(Bt[n][k], At[m][k], acc[ai][bj][m][n], 0, 0, 0); __builtin_amdgcn_s_setprio(0); } while (0)
#define PG8_WAIT_V(n) asm volatile("s_waitcnt vmcnt(" #n ")" ::: "memory")
#define PG8_WAIT_L(n) asm volatile("s_waitcnt lgkmcnt(" #n ")" ::: "memory")
#define PG8_BAR __builtin_amdgcn_s_barrier()
#define PG8_SCHED __builtin_amdgcn_sched_barrier(0)
    Unit cur, nxt; int ui = 0;
    if (!S.next(0, cur)) return;
    f32x4 acc[2][2][4][2];
#pragma unroll
    for (int a = 0; a < 2; ++a)
#pragma unroll
        for (int b = 0; b < 2; ++b)
#pragma unroll
            for (int m = 0; m < 4; ++m)
#pragma unroll
                for (int n = 0; n < 2; ++n) acc[a][b][m][n] = (f32x4){0.f, 0.f, 0.f, 0.f};
    bf16x8 At[4][2], B0[2][2], B1[2][2];
    const char* cA = (const char*)g.A + (size_t)cur.pm * g.a_tstep; const char* cB = (const char*)g.Bt + (size_t)cur.pn * g.b_tstep;
    PG8_STAGE(PG8_SB(0, 0), cB, voffB); PG8_STAGE(PG8_SB(0, 1), cB + hstepB, voffB); PG8_STAGE(PG8_SA(0, 0), cA, voffA); PG8_STAGE(PG8_SA(0, 1), cA + hstepA, voffA);
    if (wr == 1) PG8_BAR;
    PG8_WAIT_V(2); PG8_BAR;
    PG8_STAGE(PG8_SB(1, 0), cB + kstep, voffB); PG8_STAGE(PG8_SA(1, 0), cA + kstep, voffA); PG8_STAGE(PG8_SB(1, 1), cB + hstepB + kstep, voffB);
    PG8_WAIT_V(6); PG8_BAR;
    for (;;) {
        const bool has_next = S.next(ui + 1, nxt);
        const char* nA = has_next ? (const char*)g.A + (size_t)nxt.pm * g.a_tstep : cA; const char* nB = has_next ? (const char*)g.Bt + (size_t)nxt.pn * g.b_tstep : cB;
        for (int t = 0; t < nt; t += 2) {
            const bool last = (t == nt - 2);
            const char* a1 = cA + (size_t)(t + 1) * kstep;
            const char* a2 = last ? nA : cA + (size_t)(t + 2) * kstep; const char* b2 = last ? nB : cB + (size_t)(t + 2) * kstep;
            const char* a3 = a2 + kstep; const char* b3 = b2 + kstep;
            if constexpr (Epi::HOOK) { if (t == 4 || t == 12) {
                    if (wr == 0) PG8_BAR; E.hook(acc, cur, t, wr, wc, fr, fq); if (wr == 1) PG8_BAR; } }
            PG8_LDB(B0, 0, 0); PG8_LDB(B1, 0, 1); PG8_SCHED; PG8_LDA(At, 0, 0); PG8_STAGE(PG8_SA(1, 1), a1 + hstepA, voffA);
            PG8_WAIT_V(8); PG8_WAIT_L(0); PG8_BAR; PG8_MMA(0, 0, At, B0); PG8_MMA(0, 1, At, B1); PG8_BAR; PG8_SCHED;
            PG8_LDA(At, 0, 1); PG8_STAGE(PG8_SB(0, 0), b2, voffB); PG8_STAGE(PG8_SB(0, 1), b2 + hstepB, voffB); PG8_STAGE(PG8_SA(0, 0), a2, voffA);
            PG8_WAIT_V(8); PG8_WAIT_L(0); PG8_BAR; PG8_MMA(1, 0, At, B0); PG8_MMA(1, 1, At, B1); PG8_BAR; PG8_SCHED;
            PG8_LDB(B0, 1, 0); PG8_LDB(B1, 1, 1); PG8_SCHED; PG8_LDA(At, 1, 0); PG8_STAGE(PG8_SA(0, 1), a2 + hstepA, voffA);
            PG8_WAIT_V(8); PG8_WAIT_L(0); PG8_BAR; PG8_MMA(0, 0, At, B0); PG8_MMA(0, 1, At, B1); PG8_BAR; PG8_SCHED;
            PG8_LDA(At, 1, 1); PG8_STAGE(PG8_SB(1, 0), b3, voffB); PG8_STAGE(PG8_SB(1, 1), b3 + hstepB, voffB); PG8_STAGE(PG8_SA(1, 0), a3, voffA);
            PG8_WAIT_V(8); PG8_WAIT_L(0); PG8_BAR; PG8_MMA(1, 0, At, B0); PG8_MMA(1, 1, At, B1); PG8_BAR; PG8_SCHED;
        }
        if (wr == 0) PG8_BAR;
        E(acc, cur, wr, wc, fr, fq);
        if (!has_next) break;
#pragma unroll
        for (int a = 0; a < 2; ++a)
#pragma unroll
            for (int b = 0; b < 2; ++b)
#pragma unroll
                for (int m = 0; m < 4; ++m)
#pragma unroll
                    for (int n = 0; n < 2; ++n) acc[a][b][m][n] = (f32x4){0.f, 0.f, 0.f, 0.f};
        cur = nxt; cA = nA; cB = nB; ++ui;
        if (wr == 1) PG8_BAR;
    }
    PG8_WAIT_V(0);
    PG8_BAR;
#undef PG8_SA
#undef PG8_SB
#undef PG8_STAGE
#undef PG8_LDA
#undef PG8_LDB
#undef PG8_MMA
#undef PG8_WAIT_V
#undef PG8_WAIT_L
#undef PG8_BAR
#undef PG8_SCHED
}
}
using pg8::Unit;
typedef f32x4 Acc[2][2][4][2];

DI u32x4 pack8(f32x4 a, f32x4 b) { u32x4 w; w.x = pk2(a[0], a[1]); w.y = pk2(a[2], a[3]); w.z = pk2(b[0], b[1]); w.w = pk2(b[2], b[3]); return w; }
DI float sigmoidf_(float x) { return __builtin_amdgcn_rcpf(1.f + __builtin_amdgcn_exp2f(-x * LOG2E)); }


DI size_t kf_elem(int NB, int head, int tok, int d) { return ((((size_t)(head * NB + (tok >> 5)) * 4 + (d >> 4)) * 64 + ((d >> 3) & 1) * 32 + (tok & 31)) << 3) + (d & 7); }
DI size_t vf_elem(int NB, int head, int tok, int d) { const int t = tok & 31; return (((((size_t)(head * NB + (tok >> 5)) * 2 + (d >> 5)) * 4 + (t >> 3)) * 64 + ((t >> 2) & 1) * 32 + (d & 31)) << 2) + (t & 3); }

struct EpiIn {
    static constexpr bool HOOK = false, ROWPERM = false;
    bf16_t* QKU; bf16_t* GATES; const float* b_gate; bf16_t* KF;
    DI void operator()(const Acc& acc, const Unit& u, int wr, int wc, int fr, int fq) const {
        const int row0 = u.pm * 256 + wr * 64 + fr, pn = u.pn;
        if (pn == 3 || pn == 4) {
#pragma unroll
            for (int ai = 0; ai < 2; ++ai)
#pragma unroll
                for (int m = 0; m < 4; ++m)
#pragma unroll
                    for (int bj = 0; bj < 2; ++bj) { const int tok = row0 + ai * 128 + m * 16, c = (pn - 3) * 256 + bj * 128 + wc * 32 + 8 * fq;
                        *(u32x4*)(KF + kf_elem(512, c >> 6, tok, c & 63)) = pack8(acc[ai][bj][m][0], acc[ai][bj][m][1]); }
            return; }
        if (pn >= 6) {
            const int col0 = (pn - 6) * 256 + wc * 32 + 8 * fq;
            f32x4 bv[2][2];
#pragma unroll
            for (int bj = 0; bj < 2; ++bj)
#pragma unroll
                for (int n = 0; n < 2; ++n) bv[bj][n] = *(const f32x4*)(b_gate + col0 + bj * 128 + 4 * n);
#pragma unroll
            for (int ai = 0; ai < 2; ++ai)
#pragma unroll
                for (int m = 0; m < 4; ++m) { bf16_t* rowp = GATES + (size_t)(row0 + ai * 128 + m * 16) * GATE_P + col0;
#pragma unroll
                    for (int bj = 0; bj < 2; ++bj) { f32x4 v0 = acc[ai][bj][m][0] + bv[bj][0], v1 = acc[ai][bj][m][1] + bv[bj][1];
#pragma unroll
                        for (int j = 0; j < 4; ++j) { v0[j] = fmaxf(sigmoidf_(v0[j]), 1e-9f); v1[j] = fmaxf(sigmoidf_(v1[j]), 1e-9f); }
                        *(u32x4*)(rowp + bj * 128) = pack8(v0, v1); } }
            return; }
        const float sc = (pn == 1 || pn == 2 || pn == 5) ? QSCALE : 1.f;
        const int col0 = pn * 256 + wc * 32 + 8 * fq;
#pragma unroll
        for (int ai = 0; ai < 2; ++ai)
#pragma unroll
            for (int m = 0; m < 4; ++m) { bf16_t* rowp = QKU + (size_t)(row0 + ai * 128 + m * 16) * QKU_P + col0;
#pragma unroll
                for (int bj = 0; bj < 2; ++bj) *(u32x4*)(rowp + bj * 128) = pack8(acc[ai][bj][m][0] * sc, acc[ai][bj][m][1] * sc); }
    }
};
struct EpiVT {
    static constexpr bool HOOK = false, ROWPERM = false;
    bf16_t* VF;
    DI void operator()(const Acc& acc, const Unit& u, int wr, int wc, int fr, int fq) const {
        const int row0 = u.pm * 256 + wr * 64 + fr, col0 = u.pn * 256 + wc * 32 + 8 * fq;
#pragma unroll
        for (int ai = 0; ai < 2; ++ai)
#pragma unroll
            for (int m = 0; m < 4; ++m) { const int hd = row0 + ai * 128 + m * 16;
#pragma unroll
                for (int bj = 0; bj < 2; ++bj) { const int tok = col0 + bj * 128;
                    u32x2 w0, w1; w0.x = pk2(acc[ai][bj][m][0][0], acc[ai][bj][m][0][1]); w0.y = pk2(acc[ai][bj][m][0][2], acc[ai][bj][m][0][3]);
                    w1.x = pk2(acc[ai][bj][m][1][0], acc[ai][bj][m][1][1]); w1.y = pk2(acc[ai][bj][m][1][2], acc[ai][bj][m][1][3]);
                    *(u32x2*)(VF + vf_elem(512, hd >> 6, tok, hd & 63)) = w0; *(u32x2*)(VF + vf_elem(512, hd >> 6, tok + 4, hd & 63)) = w1; } }
    }
};
struct EpiMerge {
    static constexpr bool HOOK = true, ROWPERM = false;
    const bf16_t* GATES; bf16_t* MERGED;
    DI void hook(Acc& acc, const Unit& u, int t, int wr, int wc, int fr, int fq) const {
        int row0 = u.pm * 256 + wr * 64 + fr; const int col0 = u.pn * 256 + wc * 32 + 8 * fq;
        asm volatile("" : "+v"(row0));
        const int ga = (t == 4) ? 0 : D, gb = ga + D;
#pragma unroll
        for (int ai = 0; ai < 2; ++ai)
#pragma unroll
            for (int m = 0; m < 4; ++m) { const bf16_t* gp = GATES + (size_t)(row0 + ai * 128 + m * 16) * GATE_P + col0;
#pragma unroll
                for (int bj = 0; bj < 2; ++bj) { const u32x4 a = *(const u32x4*)(gp + ga + bj * 128), b = *(const u32x4*)(gp + gb + bj * 128);
                    f32x4 r0, r1;
                    r0[0] = bflo(a.x) * __builtin_amdgcn_rcpf(bflo(b.x)); r0[1] = bfhi(a.x) * __builtin_amdgcn_rcpf(bfhi(b.x));
                    r0[2] = bflo(a.y) * __builtin_amdgcn_rcpf(bflo(b.y)); r0[3] = bfhi(a.y) * __builtin_amdgcn_rcpf(bfhi(b.y));
                    r1[0] = bflo(a.z) * __builtin_amdgcn_rcpf(bflo(b.z)); r1[1] = bfhi(a.z) * __builtin_amdgcn_rcpf(bfhi(b.z));
                    r1[2] = bflo(a.w) * __builtin_amdgcn_rcpf(bflo(b.w)); r1[3] = bfhi(a.w) * __builtin_amdgcn_rcpf(bfhi(b.w));
                    acc[ai][bj][m][0] = acc[ai][bj][m][0] * r0; acc[ai][bj][m][1] = acc[ai][bj][m][1] * r1; } }
    }
    DI void operator()(const Acc& acc, const Unit& u, int wr, int wc, int fr, int fq) const {
        const int row0 = u.pm * 256 + wr * 64 + fr, col0 = u.pn * 256 + wc * 32 + 8 * fq;
#pragma unroll
        for (int ai = 0; ai < 2; ++ai)
#pragma unroll
            for (int m = 0; m < 4; ++m) { const size_t row = (size_t)(row0 + ai * 128 + m * 16);
#pragma unroll
                for (int bj = 0; bj < 2; ++bj) { const u32x4 a = *(const u32x4*)(GATES + row * GATE_P + 2 * D + col0 + bj * 128);
                    const f32x4 g0 = {bflo(a.x), bfhi(a.x), bflo(a.y), bfhi(a.y)}, g1 = {bflo(a.z), bfhi(a.z), bflo(a.w), bfhi(a.w)};
                    *(u32x4*)(MERGED + row * D + col0 + bj * 128) = pack8(acc[ai][bj][m][0] * g0, acc[ai][bj][m][1] * g1); } }
    }
};
template <bool IN_BF16>
struct EpiResid {
    static constexpr bool HOOK = false, ROWPERM = false;
    const float* XI; bf16_t* XB; float* PART;
    DI void operator()(const Acc& acc, const Unit& u, int wr, int wc, int fr, int fq) const {
        const int row0 = u.pm * 256 + wr * 64 + fr, col0 = u.pn * 256 + wc * 32 + 8 * fq;
#pragma unroll
        for (int ai = 0; ai < 2; ++ai) {
            f32x4 xin[4][2][2];
#pragma unroll
            for (int m = 0; m < 4; ++m)
#pragma unroll
                for (int bj = 0; bj < 2; ++bj) { const size_t off = (size_t)(row0 + ai * 128 + m * 16) * D + col0 + bj * 128;
                    if (IN_BF16) { const u32x4 a = *(const u32x4*)(XB + off); xin[m][bj][0] = (f32x4){bflo(a.x), bfhi(a.x), bflo(a.y), bfhi(a.y)}; xin[m][bj][1] = (f32x4){bflo(a.z), bfhi(a.z), bflo(a.w), bfhi(a.w)}; }
                    else { xin[m][bj][0] = *(const f32x4*)(XI + off); xin[m][bj][1] = *(const f32x4*)(XI + off + 4); } }
            __builtin_amdgcn_sched_barrier(0);
#pragma unroll
            for (int m = 0; m < 4; ++m) { const size_t row = (size_t)(row0 + ai * 128 + m * 16); float ss = 0.f;
#pragma unroll
                for (int bj = 0; bj < 2; ++bj) { const size_t off = row * D + col0 + bj * 128;
                    const f32x4 v0 = xin[m][bj][0] + acc[ai][bj][m][0], v1 = xin[m][bj][1] + acc[ai][bj][m][1];
                    *(u32x4*)(XB + off) = pack8(v0, v1);
                    ss += (v0[0] * v0[0] + v0[1] * v0[1]) + (v0[2] * v0[2] + v0[3] * v0[3]) + (v1[0] * v1[0] + v1[1] * v1[1]) + (v1[2] * v1[2] + v1[3] * v1[3]); }
                ss += __shfl_xor(ss, 16); ss += __shfl_xor(ss, 32);
                if (fq == 0) PART[row * 16 + u.pn * 4 + wc] = ss; }
        }
    }
};
struct EpiFfnUp {
    static constexpr bool HOOK = false, ROWPERM = true;
    bf16_t* ACT; const LAS float* RS; const float* conv_w; const float* conv_b; bf16_t* DUMP;
    DI void operator()(const Acc& acc, const Unit& u, int wr, int wc, int fr, int fq) const {
        const int r0 = 252 * u.pm - 2 + 126 * wr + 8 * fr;
        float rs[8];
        const LAS float* rsp = RS + (u.idx * 256 + wr * 128 + 8 * fr);
        { const f32x4 ra = *(const LAS f32x4*)rsp, rb = *(const LAS f32x4*)(rsp + 4); rs[0] = ra[0]; rs[1] = ra[1]; rs[2] = ra[2]; rs[3] = ra[3]; rs[4] = rb[0]; rs[5] = rb[1]; rs[6] = rb[2]; rs[7] = rb[3]; }
        const int j0 = 128 * u.pn + 32 * wc + 8 * fq;
#pragma unroll
        for (int n = 0; n < 2; ++n) {
            const int jc = j0 + 4 * n;
            const f32x4 wg0 = *(const f32x4*)(conv_w + jc), wg1 = *(const f32x4*)(conv_w + 2 * DFF + jc), wg2 = *(const f32x4*)(conv_w + 4 * DFF + jc), bg = *(const f32x4*)(conv_b + jc);
            const f32x4 wv0 = *(const f32x4*)(conv_w + DFF + jc), wv1 = *(const f32x4*)(conv_w + 3 * DFF + jc), wv2 = *(const f32x4*)(conv_w + 5 * DFF + jc), bv = *(const f32x4*)(conv_b + DFF + jc);
            f32x4 g[8], v[8];
#pragma unroll
            for (int i = 0; i < 8; ++i) { g[i] = acc[i >> 2][0][i & 3][n] * rs[i]; v[i] = acc[i >> 2][1][i & 3][n] * rs[i]; }
            f32x4 gp6, gp7, vp6, vp7;
#pragma unroll
            for (int j = 0; j < 4; ++j) {
                gp6[j] = dpp_shr1(g[6][j]);
                gp7[j] = dpp_shr1(g[7][j]);
                vp6[j] = dpp_shr1(v[6][j]);
                vp7[j] = dpp_shr1(v[7][j]); }
#pragma unroll
            for (int i = 7; i >= 0; --i) {
                const f32x4 gm1 = (i >= 1) ? g[i - 1] : gp7, gm2 = (i >= 2) ? g[i - 2] : (i == 1 ? gp7 : gp6);
                const f32x4 vm1 = (i >= 1) ? v[i - 1] : vp7, vm2 = (i >= 2) ? v[i - 2] : (i == 1 ? vp7 : vp6);
                const f32x4 cg = bg + wg2 * g[i] + wg1 * gm1 + wg0 * gm2;
                const f32x4 cv = bv + wv2 * v[i] + wv1 * vm1 + wv0 * vm2;
                const f32x2 ga = gelu_pk((f32x2){cg[0], cg[1]}), gb = gelu_pk((f32x2){cg[2], cg[3]});
                const int row = r0 + i;
                u32x2 w; w.x = pk2(ga.x * cv[0], ga.y * cv[1]); w.y = pk2(gb.x * cv[2], gb.y * cv[3]);
                bf16_t* dst = ((8 * fr + i >= 2) && row < S) ? ACT + (size_t)row * DFF + jc : DUMP + (((wr * 4 + wc) * 64 + fq * 16 + fr) << 2);
                *(u32x2*)dst = w;
            }
        }
    }
};

#define MFMA32(a, b, c) __builtin_amdgcn_mfma_f32_32x32x16_bf16((a), (b), (c), 0, 0, 0)
DI int crow(int i, int g) { return (i & 3) + 8 * (i >> 2) + 4 * g; }
DI void attn_step(bf16x8 (&kf)[4], const char* kbase, unsigned& koff, const s16x4 (&v0)[4], const s16x4 (&v1)[4], const LAS bf16x8* ql, f32x16 (&o)[2][2], float (&mrun)[2], float (&lrun)[2],
                  int it, int jt0, const LAS float* bias, bool has_bias, int r, int g) {
    f32x16 s[2];
#pragma unroll
    for (int qb = 0; qb < 2; ++qb)
#pragma unroll
        for (int i = 0; i < 16; ++i) s[qb][i] = 0.f;
#pragma unroll
    for (int st = 0; st < 4; ++st) {
        if ((st & 1) == 0) asm volatile("" ::: "memory");
#pragma unroll
        for (int qb = 0; qb < 2; ++qb) s[qb] = MFMA32(kf[st], ql[(qb * 4 + st) * 64], s[qb]);
    }
    koff += 4096u;
#pragma unroll
    for (int st = 0; st < 4; ++st) kf[st] = *(const bf16x8*)(kbase + koff + 1024 * st);
    if (has_bias) { const int jt = jt0 + (it >> 1);
        if (jt <= 5) { const float c = bias[256];
#pragma unroll
            for (int qb = 0; qb < 2; ++qb)
#pragma unroll
                for (int i = 0; i < 16; ++i) s[qb][i] += c;
        } else { const LAS float* bp = bias + (64 * (8 - jt) + 128 - 32 * (it & 1) + r - 4 * g - 27);
#pragma unroll
            for (int qb = 0; qb < 2; ++qb)
#pragma unroll
                for (int i = 0; i < 16; ++i) s[qb][i] += bp[27 + 32 * qb - ((i & 3) + 8 * (i >> 2))];
        } }
    float mn[2];
#pragma unroll
    for (int qb = 0; qb < 2; ++qb) {
        float m = fmaxf(fmaxf(s[qb][0], s[qb][1]), s[qb][2]);
#pragma unroll
        for (int i = 3; i < 15; i += 2) m = fmaxf(fmaxf(m, s[qb][i]), s[qb][i + 1]);
        m = fmaxf(m, s[qb][15]);
        mn[qb] = fmaxf(mrun[qb], xhalf_max(m));
    }
    if (__any((mn[0] > mrun[0]) || (mn[1] > mrun[1]))) {
#pragma unroll
        for (int qb = 0; qb < 2; ++qb) {
            const float al = __builtin_amdgcn_exp2f(mrun[qb] - mn[qb]); mrun[qb] = mn[qb];
            lrun[qb] *= al;
#pragma unroll
            for (int db = 0; db < 2; ++db)
#pragma unroll
                for (int i = 0; i < 16; ++i) o[db][qb][i] *= al;
        }
    }
#pragma unroll
    for (int qb = 0; qb < 2; ++qb) {
        float ls = 0.f;
#pragma unroll
        for (int i = 0; i < 16; ++i) { const float p = __builtin_amdgcn_exp2f(s[qb][i] - mn[qb]); s[qb][i] = p; ls += p; }
        lrun[qb] += ls;
    }
#pragma unroll
    for (int sp = 0; sp < 2; ++sp) {
        bf16x8 pf[2];
#pragma unroll
        for (int qb = 0; qb < 2; ++qb) { u32x4 w; w.x = pk2(s[qb][8 * sp + 0], s[qb][8 * sp + 1]); w.y = pk2(s[qb][8 * sp + 2], s[qb][8 * sp + 3]);
            w.z = pk2(s[qb][8 * sp + 4], s[qb][8 * sp + 5]); w.w = pk2(s[qb][8 * sp + 6], s[qb][8 * sp + 7]); pf[qb] = __builtin_bit_cast(bf16x8, w); }
        const bf16x8 vf0 = __builtin_shufflevector(v0[2 * sp], v0[2 * sp + 1], 0, 1, 2, 3, 4, 5, 6, 7);
        const bf16x8 vf1 = __builtin_shufflevector(v1[2 * sp], v1[2 * sp + 1], 0, 1, 2, 3, 4, 5, 6, 7);
#pragma unroll
        for (int qb = 0; qb < 2; ++qb) { o[0][qb] = MFMA32(vf0, pf[qb], o[0][qb]); o[1][qb] = MFMA32(vf1, pf[qb], o[1][qb]); }
    }
}
#define ATTN_LOADV(v0_, v1_) do { _Pragma("unroll") for (int j = 0; j < 4; ++j) { v0_[j] = *(const s16x4*)(vbase + voff + 512 * j); v1_[j] = *(const s16x4*)(vbase + voff + 2048 + 512 * j); } voff += 4096u; } while (0)
DI void attn_wave(const bf16_t* Q, int qp, const bf16_t* KFp, const bf16_t* VFp, int nsteps, int jt0,
                  const LAS float* bias, bool has_bias, bf16_t* O, int op, int lane_in, LAS unsigned char* qlds) {
    int lane = lane_in; asm volatile("" : "+v"(lane));
    const int r = lane & 31, g = lane >> 5;
    LAS bf16x8* ql = (LAS bf16x8*)qlds + lane;
#pragma unroll
    for (int qb = 0; qb < 2; ++qb)
#pragma unroll
        for (int st = 0; st < 4; ++st) ql[(qb * 4 + st) * 64] = *(const bf16x8*)(Q + (size_t)(32 * qb + r) * qp + 16 * st + 8 * g);
    f32x16 o[2][2]; float mrun[2] = {-1e30f, -1e30f}, lrun[2] = {0.f, 0.f};
#pragma unroll
    for (int a = 0; a < 2; ++a)
#pragma unroll
        for (int b = 0; b < 2; ++b)
#pragma unroll
            for (int i = 0; i < 16; ++i) o[a][b][i] = 0.f;
    const char* kbase = (const char*)KFp; const char* vbase = (const char*)VFp;
    unsigned koff = (unsigned)lane * 16u, voff = (unsigned)lane * 8u;
    bf16x8 kf[4]; s16x4 v0A[4], v1A[4], v0B[4], v1B[4];
#pragma unroll
    for (int st = 0; st < 4; ++st) kf[st] = *(const bf16x8*)(kbase + koff + 1024 * st);
    ATTN_LOADV(v0A, v1A);
    for (int it = 0; it < nsteps; it += 2) {
        ATTN_LOADV(v0B, v1B);
        attn_step(kf, kbase, koff, v0A, v1A, ql, o, mrun, lrun, it, jt0, bias, has_bias, r, g);
        ATTN_LOADV(v0A, v1A);
        attn_step(kf, kbase, koff, v0B, v1B, ql, o, mrun, lrun, it + 1, jt0, bias, has_bias, r, g);
    }
    int l2 = lane; asm volatile("" : "+v"(l2));
    const int r2 = l2 & 31, g2 = l2 >> 5;
#pragma unroll
    for (int qb = 0; qb < 2; ++qb) { const float inv = 1.f / xhalf_sum(lrun[qb]);
#pragma unroll
        for (int db = 0; db < 2; ++db)
#pragma unroll
            for (int ig = 0; ig < 4; ++ig) { u32x2 w; w.x = pk2(o[db][qb][4 * ig] * inv, o[db][qb][4 * ig + 1] * inv); w.y = pk2(o[db][qb][4 * ig + 2] * inv, o[db][qb][4 * ig + 3] * inv);
                *(u32x2*)(O + (size_t)(32 * qb + r2) * op + 32 * db + 8 * ig + 4 * g2) = w; } }
}

template <int WIN> DI void pool_lane(const bf16_t* U, bf16_t* OC, int t0) {
    u32x4 rows[WIN + 7];
#pragma unroll
    for (int j = 0; j < WIN + 7; ++j) { const int t = t0 - WIN + 1 + j; rows[j] = (t >= 0) ? *(const u32x4*)(U + (size_t)t * QKU_P) : (u32x4){0u, 0u, 0u, 0u}; }
    float sm[8];
#pragma unroll
    for (int c = 0; c < 8; ++c) sm[c] = 0.f;
#pragma unroll
    for (int j = 0; j < WIN; ++j) { const u32x4 a = rows[j];
        sm[0] += bflo(a.x); sm[1] += bfhi(a.x); sm[2] += bflo(a.y); sm[3] += bfhi(a.y); sm[4] += bflo(a.z); sm[5] += bfhi(a.z); sm[6] += bflo(a.w); sm[7] += bfhi(a.w); }
#pragma unroll
    for (int k = 0; k < 8; ++k) { const int t = t0 + k; const u32x4 a = rows[k + WIN - 1];
        if (k > 0) { const u32x4 b = rows[k - 1];
            sm[0] += bflo(a.x) - bflo(b.x); sm[1] += bfhi(a.x) - bfhi(b.x); sm[2] += bflo(a.y) - bflo(b.y); sm[3] += bfhi(a.y) - bfhi(b.y);
            sm[4] += bflo(a.z) - bflo(b.z); sm[5] += bfhi(a.z) - bfhi(b.z); sm[6] += bflo(a.w) - bflo(b.w); sm[7] += bfhi(a.w) - bfhi(b.w); }
        const float ic = 1.f / (float)((t + 1 < WIN) ? t + 1 : WIN);
        u32x4 w; w.x = pk2(sm[0] * ic - bflo(a.x), sm[1] * ic - bfhi(a.x)); w.y = pk2(sm[2] * ic - bflo(a.y), sm[3] * ic - bfhi(a.y));
        w.z = pk2(sm[4] * ic - bflo(a.z), sm[5] * ic - bfhi(a.z)); w.w = pk2(sm[6] * ic - bflo(a.w), sm[7] * ic - bfhi(a.w));
        *(u32x4*)(OC + (size_t)t * D) = w; }
}

DI void transpose_item(const float* W, int N, bf16_t* WT, int ldt, int koff, int row_off, const float* kscale, LAS float* scr, int kb, int nb, int lane) {
    const int k0 = 64 * kb, n0 = 32 * nb;
    const float* wp = W + (size_t)(k0 + (lane >> 5)) * N + n0 + (lane & 31);
    float v[32];
#pragma unroll
    for (int i = 0; i < 32; ++i) v[i] = wp[(size_t)(2 * i) * N];
#pragma unroll
    for (int i = 0; i < 32; ++i) scr[(2 * i + (lane >> 5)) * 33 + (lane & 31)] = v[i];
    asm volatile("s_waitcnt lgkmcnt(0)" ::: "memory");
    const int c = lane & 7;
    float gs[8];
#pragma unroll
    for (int j = 0; j < 8; ++j) gs[j] = kscale ? kscale[k0 + 8 * c + j] : 1.f;
#pragma unroll
    for (int j = 0; j < 4; ++j) { const int n = (lane >> 3) + 8 * j; const LAS float* s = scr + (8 * c) * 33 + n;
        u32x4 o; o.x = pk2(s[0 * 33] * gs[0], s[1 * 33] * gs[1]); o.y = pk2(s[2 * 33] * gs[2], s[3 * 33] * gs[3]); o.z = pk2(s[4 * 33] * gs[4], s[5 * 33] * gs[5]); o.w = pk2(s[6 * 33] * gs[6], s[7 * 33] * gs[7]);
        *(u32x4*)(WT + (size_t)(row_off + n0 + n) * ldt + koff + k0 + 8 * c) = o; }
    asm volatile("s_waitcnt lgkmcnt(0)" ::: "memory");
}

#define XB_TMO      128
#define XB_XCNT(j)  (256  + 64 * (j))
#define XB_XSUB(j)  (1280 + 64 * (j))
#define XB_XGEN(j)  (2304 + 64 * (j))
#define XB_TOP      3328
#define XB_TOPGEN   3392
#define XCD_BAR_WORDS 3456
#define XB_SPIN_CAP (1u << 20)
DI unsigned xb_ld(unsigned* p)              { return __hip_atomic_load(p, __ATOMIC_RELAXED, __HIP_MEMORY_SCOPE_AGENT); }
DI unsigned xb_add(unsigned* p, unsigned v) { return __hip_atomic_fetch_add(p, v, __ATOMIC_RELAXED, __HIP_MEMORY_SCOPE_AGENT); }
DI unsigned xb_xcc_id() { return (unsigned)__builtin_amdgcn_s_getreg((3 << 11) | 20) & 0xFu; }
#define XB_SPIN(cond, bar) do { unsigned _sp = 0; while (cond) { __builtin_amdgcn_s_sleep(1); \
    if ((++_sp & 255u) == 0u) { if (xb_ld(&(bar)[XB_TMO])) break; if (_sp > XB_SPIN_CAP) { atomicAdd(&(bar)[XB_TMO], 1u); break; } } } } while (0)
DI void xcd_barrier_complete(unsigned* bar, unsigned x, unsigned G, unsigned& nloc, unsigned& nx) {
    unsigned sum, cnt, mine, sp = 0u;
    for (;;) {
        sum = 0u; cnt = 0u; mine = 0u;
#pragma unroll
        for (unsigned j = 0; j < 16; ++j) { const unsigned c = xb_ld(&bar[XB_XCNT(j)]); sum += c; cnt += (c > 0u) ? 1u : 0u; mine = (j == x) ? c : mine; }
        if (sum == G) break;
        __builtin_amdgcn_s_sleep(1);
        if ((++sp & 255u) == 0u) { if (xb_ld(&bar[XB_TMO])) break; if (sp > XB_SPIN_CAP) { atomicAdd(&bar[XB_TMO], 1u); break; } }
    }
    nloc = mine > 0u ? mine : 1u; nx = cnt > 0u ? cnt : 1u;
}
DI void grid_bar(unsigned* bar, volatile LAS unsigned* st, unsigned G, int wave) {
    asm volatile("s_waitcnt vmcnt(0)" ::: "memory");
    __syncthreads();
    if (wave == 0) { if (lane_id_v() == 0) {
        __builtin_amdgcn_s_waitcnt(0);
        const unsigned x = xb_xcc_id();
        unsigned nloc = st[0], nx = st[1];
        if (nloc == 0u) { xcd_barrier_complete(bar, x, G, nloc, nx); st[0] = nloc; st[1] = nx; }
        const unsigned old = xb_add(&bar[XB_XSUB(x)], 1u);
        const unsigned gen = old / nloc;
        if (old + 1u == (gen + 1u) * nloc) {
            __builtin_amdgcn_fence(__ATOMIC_RELEASE, "agent");
            asm volatile("s_waitcnt vmcnt(0)" ::: "memory");
            const unsigned og = xb_add(&bar[XB_TOP], 1u);
            const unsigned tg = og / nx;
            if (og + 1u == (tg + 1u) * nx) xb_add(&bar[XB_TOPGEN], 1u);
            else XB_SPIN(xb_ld(&bar[XB_TOPGEN]) == tg, bar);
            __builtin_amdgcn_fence(__ATOMIC_ACQUIRE, "agent");
            xb_add(&bar[XB_XGEN(x)], 1u);
            asm volatile("s_waitcnt vmcnt(0)" ::: "memory");
        } else {
            XB_SPIN(xb_ld(&bar[XB_XGEN(x)]) == gen, bar);
            __builtin_amdgcn_fence(__ATOMIC_ACQUIRE, "agent");
            asm volatile("s_waitcnt vmcnt(0)" ::: "memory");
        }
    } }
    __syncthreads();
}

struct EpiFinal {
    static constexpr bool HOOK = false, ROWPERM = false;
    const bf16_t* XB; float* OUT; float* PARTF; unsigned* CNT; const float* gfin; unsigned* tmo;
    DI void operator()(Acc& acc, const Unit& u, int wr, int wc, int fr, int fq) const {
        const int row0 = u.pm * 256 + wr * 64 + fr, col0 = u.pn * 256 + wc * 32 + 8 * fq;
        u32x4 xin[16];
#pragma unroll
        for (int ai = 0; ai < 2; ++ai)
#pragma unroll
            for (int m = 0; m < 4; ++m)
#pragma unroll
                for (int bj = 0; bj < 2; ++bj) xin[(ai * 4 + m) * 2 + bj] = *(const u32x4*)(XB + (size_t)(row0 + ai * 128 + m * 16) * D + col0 + bj * 128);
        __builtin_amdgcn_sched_barrier(0);
#pragma unroll
        for (int ai = 0; ai < 2; ++ai)
#pragma unroll
            for (int m = 0; m < 4; ++m) { const size_t row = (size_t)(row0 + ai * 128 + m * 16); float ss = 0.f;
#pragma unroll
                for (int bj = 0; bj < 2; ++bj) { const u32x4 a = xin[(ai * 4 + m) * 2 + bj];
                    const f32x4 v0 = (f32x4){bflo(a.x), bfhi(a.x), bflo(a.y), bfhi(a.y)} + acc[ai][bj][m][0], v1 = (f32x4){bflo(a.z), bfhi(a.z), bflo(a.w), bfhi(a.w)} + acc[ai][bj][m][1];
                    acc[ai][bj][m][0] = v0; acc[ai][bj][m][1] = v1;
                    ss += (v0[0] * v0[0] + v0[1] * v0[1]) + (v0[2] * v0[2] + v0[3] * v0[3]) + (v1[0] * v1[0] + v1[1] * v1[1]) + (v1[2] * v1[2] + v1[3] * v1[3]); }
                ss += __shfl_xor(ss, 16); ss += __shfl_xor(ss, 32);
                if (fq == 0) PARTF[((size_t)u.pn * S + row) * 4 + wc] = ss; }
        asm volatile("s_waitcnt vmcnt(0)" ::: "memory");
        __builtin_amdgcn_s_barrier();
        if (wr == 0 && wc == 0) { if (lane_id_v() == 0) {
            __builtin_amdgcn_fence(__ATOMIC_RELEASE, "agent");
            asm volatile("s_waitcnt vmcnt(0)" ::: "memory");
            xb_add(CNT + 64 * u.pm, 1u);
            XB_SPIN(xb_ld(CNT + 64 * u.pm) < 4u, tmo - XB_TMO);
            __builtin_amdgcn_fence(__ATOMIC_ACQUIRE, "agent");
            asm volatile("s_waitcnt vmcnt(0)" ::: "memory");
        } }
        __builtin_amdgcn_s_barrier();
        asm volatile("" ::: "memory");
        f32x4 gv[2][2];
#pragma unroll
        for (int bj = 0; bj < 2; ++bj)
#pragma unroll
            for (int n = 0; n < 2; ++n) gv[bj][n] = *(const f32x4*)(gfin + col0 + bj * 128 + 4 * n);
#pragma unroll
        for (int ai = 0; ai < 2; ++ai)
#pragma unroll
            for (int m = 0; m < 4; ++m) { const size_t row = (size_t)(row0 + ai * 128 + m * 16);
                const f32x4 p0 = *(const f32x4*)(PARTF + ((size_t)0 * S + row) * 4), p1 = *(const f32x4*)(PARTF + ((size_t)1 * S + row) * 4),
                            p2 = *(const f32x4*)(PARTF + ((size_t)2 * S + row) * 4), p3 = *(const f32x4*)(PARTF + ((size_t)3 * S + row) * 4);
                const f32x4 t = (p0 + p1) + (p2 + p3);
                const float rstd = __builtin_amdgcn_rsqf(((t[0] + t[1]) + (t[2] + t[3])) * (1.f / D) + EPS);
#pragma unroll
                for (int bj = 0; bj < 2; ++bj) { float* op = OUT + row * D + col0 + bj * 128;
                    *(f32x4*)op = acc[ai][bj][m][0] * gv[bj][0] * rstd; *(f32x4*)(op + 4) = acc[ai][bj][m][1] * gv[bj][1] * rstd; } }
    }
};

#ifdef DIAG
DI float bfv(const bf16_t* p) { return __builtin_bit_cast(float, (unsigned)(*p) << 16); }
DI float dotbb(const bf16_t* a, const bf16_t* b, int n) { float s = 0.f; for (int k = 0; k < n; ++k) s += bfv(a + k) * bfv(b + k); return s; }
DI unsigned hsh(unsigned x) { x ^= x >> 16; x *= 0x7feb352du; x ^= x >> 15; x *= 0x846ca68bu; x ^= x >> 16; return x; }
DI int srow(int tid) { return tid < 64 ? ((tid & 7) + 126 * (tid >> 3)) : (tid < 80 ? S - 1 - (tid - 64) : (int)(hsh(tid) % S)); }
DI void chk(unsigned* dg, int code, float got, float exp, float rel, float abs_) { if (!(fabsf(got - exp) <= rel * fabsf(exp) + abs_)) atomicMin(dg, (unsigned)code); }
#define DCHK(code, got, exp, rel, abs_) chk(dg, code, got, exp, rel, abs_)
#endif

struct Args { const float* in[20]; float* out; unsigned char* ws; int ph_lo, ph_hi; };

__global__ void __launch_bounds__(NWAVES * 64, 2) fwd_kernel(Args args) {
    extern __shared__ __attribute__((aligned(16))) unsigned char lds_raw[];
    LAS unsigned char* lds = (LAS unsigned char*)lds_raw;
    cg::grid_group grid = cg::this_grid();
    const int wave = __builtin_amdgcn_readfirstlane((int)threadIdx.x >> 6);
    const int G = gridDim.x, bx = blockIdx.x;
    const int vcu = (G % 8 == 0) ? (bx % 8) * (G / 8) + bx / 8 : bx;
    unsigned char* ws = args.ws;
    const float* x = args.in[0]; const float* mem = args.in[1]; const float* g_mix = args.in[2]; const float* g_mem = args.in[3];
    const float* w_in = args.in[4]; const float* b_gate = args.in[5]; const float* w_pool = args.in[6]; const float* pool_scale = args.in[7];
    const float* rel_bias = args.in[8]; const float* w_mem_kv = args.in[9]; const float* w_up_pool = args.in[10]; const float* w_up_attn = args.in[11];
    const float* w_up_mem = args.in[12]; const float* w_out = args.in[13]; const float* g_ffn = args.in[14]; const float* w_ffn_up = args.in[15];
    const float* conv_w = args.in[16]; const float* conv_b = args.in[17]; const float* w_ffn_down = args.in[18]; const float* g_final = args.in[19];
    float* out = args.out;
    bf16_t* WIN = (bf16_t*)(ws + WS_WIN); bf16_t* WUP = (bf16_t*)(ws + WS_WUP); bf16_t* WOUT = (bf16_t*)(ws + WS_WOUT); bf16_t* WFUP = (bf16_t*)(ws + WS_WFUP); bf16_t* WDN = (bf16_t*)(ws + WS_WDN);
    bf16_t* KM = (bf16_t*)(ws + WS_KM); bf16_t* VMT = (bf16_t*)(ws + WS_VMT); float* PART = (float*)(ws + WS_PART); float* PART2 = (float*)(ws + WS_PART2);
    bf16_t* R1 = (bf16_t*)(ws + WS_R1); bf16_t* QKU = (bf16_t*)(ws + WS_QKU); bf16_t* GATES = (bf16_t*)(ws + WS_GATES); bf16_t* VTb = (bf16_t*)(ws + WS_VT); bf16_t* KFb = (bf16_t*)(ws + WS_KF);
    bf16_t* MERGED = (bf16_t*)(ws + WS_MERGED); bf16_t* ACT = (bf16_t*)(ws + WS_ACT);
    const int lo = args.ph_lo, hi = args.ph_hi;
#define IN(k) (lo <= (k) && (k) < hi)
#ifdef REPEAT_PHASE
#define REP(k) (((k) == REPEAT_PHASE) ? 2 : 1)
#else
#define REP(k) 1
#endif
#ifdef DELAY_PHASE
#define PH_T0(k) const unsigned long long _pt0_##k = ((k) == DELAY_PHASE) ? rt_v() : 0ull
#define PH_T1(k) do { if ((k) == DELAY_PHASE) { const unsigned long long _t1 = rt_v(); while (rt_v() < _t1 + (_t1 - _pt0_##k)) __builtin_amdgcn_s_sleep(8); } } while (0)
#else
#define PH_T0(k)
#define PH_T1(k)
#endif
    unsigned* barw = (unsigned*)(ws + WS_BAR);
    volatile LAS unsigned* bst = (volatile LAS unsigned*)(lds + LDS_MISC);
    if (wave == 0) { if (lane_id_v() == 0) { bst[0] = 0u; bst[1] = 0u; } }
#define GBAR() grid_bar(barw, bst, (unsigned)G, wave)
#ifdef DIAG
#define GSYNC0() do { grid.sync(); if (wave == 0) { if (lane_id_v() == 0) (void)xb_add(&barw[XB_XCNT(xb_xcc_id())], 1u); } } while (0)
#else
    if (lo == 0 && hi > 1) {
        unsigned* ready = barw + 12288; const int tid0 = wave * 64 + lane_id_v();
        if (bx == 0) {
            for (int i = tid0; i < 4160 + 64 * 64; i += 512) __hip_atomic_store(barw + i, 0u, __ATOMIC_RELAXED, __HIP_MEMORY_SCOPE_AGENT);
            asm volatile("s_waitcnt vmcnt(0)" ::: "memory");
            __syncthreads();
            if (tid0 == 0) { __builtin_amdgcn_fence(__ATOMIC_RELEASE, "agent"); asm volatile("s_waitcnt vmcnt(0)" ::: "memory");
                (void)__hip_atomic_exchange(ready, 0x600DF00Du, __ATOMIC_RELAXED, __HIP_MEMORY_SCOPE_AGENT); }
        } else if (tid0 == 0) {
            unsigned sp = 0; while (xb_ld(ready) != 0x600DF00Du) { __builtin_amdgcn_s_sleep(1); if (++sp > XB_SPIN_CAP) break; }
            __builtin_amdgcn_fence(__ATOMIC_ACQUIRE, "agent"); asm volatile("s_waitcnt vmcnt(0)" ::: "memory");
        }
        __syncthreads();
        if (tid0 == 0) (void)xb_add(&barw[XB_XCNT(xb_xcc_id())], 1u);
    }
    if (args.ph_lo < 0) grid.sync();
#define GSYNC0() GBAR()
#endif
#if defined(DELAY_PHASE) && DELAY_PHASE == 8
#define SEAM(k) do { if (IN(k) && IN((k) + 1)) { const unsigned long long _b0 = rt_v(); if ((k) == 0) GSYNC0(); else GBAR(); const unsigned long long _b1 = rt_v(); while (rt_v() < _b1 + (_b1 - _b0)) __builtin_amdgcn_s_sleep(8); } } while (0)
#elif defined(DOUBLE_BAR)
#define SEAM(k) do { if (IN(k) && IN((k) + 1)) { if ((k) == 0) GSYNC0(); else GBAR(); GBAR(); } } while (0)
#else
#define SEAM(k) do { if (IN(k) && IN((k) + 1)) { if ((k) == 0) GSYNC0(); else GBAR(); } } while (0)
#endif

    PH_T0(0);
    for (int rep = 0; rep < REP(0); ++rep) if (IN(0)) {
        const int lane = lane_id_v(), tid = wave * 64 + lane;
        LAS float* scr = (LAS float*)(lds + wave * 16384);
        const int gw = wave * G + vcu, NGW = G * NWAVES;
        if (bx == 0) { for (int i = tid; i < 1024; i += 512) ((unsigned*)(ws + WS_R1 - 4096))[i] = 0u;
#ifdef DIAG
            for (int i = tid; i < 4160 + 64 * 64; i += 512) __hip_atomic_store(barw + i, (i == 4096) ? 0x7fffffffu : 0u, __ATOMIC_RELAXED, __HIP_MEMORY_SCOPE_AGENT);
#endif

            if (false) __hip_atomic_store(barw + 4096, 0x7fffffffu, __ATOMIC_RELAXED, __HIP_MEMORY_SCOPE_AGENT); }
        constexpr int I_MKV = 128, I_WP = 512;
        constexpr int I_IN = 16 * 160, I_UA = 8 * 32, I_UM = 4 * 32, I_WO = 16 * 32, I_FU = 16 * 176, I_FD = 44 * 32;
        constexpr int I_ROWS = S / 2;
        constexpr int NITEMS = I_WP + I_IN + I_UA + I_UM + I_WO + I_FU + I_FD + I_ROWS;
        if (vcu < I_MKV) {
            const int nb = vcu >> 3, mb = vcu & 7, rr = lane & 31, gg = lane >> 5; const int n0 = 32 * nb, m0 = 32 * mb;
            f32x16 acc; for (int i = 0; i < 16; ++i) acc[i] = 0.f;
            float ss = 0.f;
            const float* mrow = mem + (size_t)(m0 + rr) * D;
#pragma unroll 8
            for (int k0 = 128 * wave; k0 < 128 * wave + 128; k0 += 16) { const int kk = k0 + 8 * gg;
                const f32x4 a0 = *(const f32x4*)(mrow + kk), a1 = *(const f32x4*)(mrow + kk + 4), g0 = *(const f32x4*)(g_mem + kk), g1 = *(const f32x4*)(g_mem + kk + 4);
                ss += (a0[0] * a0[0] + a0[1] * a0[1]) + (a0[2] * a0[2] + a0[3] * a0[3]) + (a1[0] * a1[0] + a1[1] * a1[1]) + (a1[2] * a1[2] + a1[3] * a1[3]);
                const bf16x8 bfr = __builtin_bit_cast(bf16x8, pack8(a0 * g0, a1 * g1));
                float wv[8];
#pragma unroll
                for (int j = 0; j < 8; ++j) wv[j] = w_mem_kv[(size_t)(kk + j) * 512 + n0 + rr];
                u32x4 wa; wa.x = pk2(wv[0], wv[1]); wa.y = pk2(wv[2], wv[3]); wa.z = pk2(wv[4], wv[5]); wa.w = pk2(wv[6], wv[7]);
                acc = MFMA32(__builtin_bit_cast(bf16x8, wa), bfr, acc); }
#pragma unroll
            for (int i = 0; i < 16; ++i) scr[i * 64 + lane] = acc[i];
            scr[1024 + lane] = ss;
            __syncthreads();
            if (wave == 0) {
#pragma unroll
                for (int w = 1; w < 8; ++w) { const LAS float* pw = (const LAS float*)(lds + w * 16384);
#pragma unroll
                    for (int i = 0; i < 16; ++i) acc[i] += pw[i * 64 + lane];
                    ss += pw[1024 + lane]; }
                ss += __shfl_xor(ss, 32);
                const float rstd = __builtin_amdgcn_rsqf(ss * (1.f / D) + EPS);
                const int mI = m0 + rr;
                if (n0 < 256) {
#pragma unroll
                    for (int ig = 0; ig < 4; ++ig) { u32x2 w; w.x = pk2(acc[4 * ig] * rstd, acc[4 * ig + 1] * rstd); w.y = pk2(acc[4 * ig + 2] * rstd, acc[4 * ig + 3] * rstd);
                        *(u32x2*)(KM + kf_elem(8, n0 >> 6, mI, (n0 & 63) + 8 * ig + 4 * gg)) = w; }
                } else {
#pragma unroll
                    for (int i = 0; i < 16; ++i) { const int nn = n0 - 256 + crow(i, gg); VMT[vf_elem(8, nn >> 6, mI, nn & 63)] = (bf16_t)(pk2(acc[i] * rstd, 0.f) & 0xffffu); }
                }
            }
            __syncthreads();
        }
        for (int it = gw; it < NITEMS; it += NGW) {
            int r = it;
            if (r < I_WP) {
                const int gI = r >> 7, c0 = ((r >> 4) & 7) * 8, n = (r & 15) * 64 + lane;
                float a[8]; for (int i = 0; i < 8; ++i) a[i] = 0.f;
#pragma unroll 64
                for (int d = 0; d < 64; ++d) { const float wv = w_up_pool[(size_t)(gI * 64 + d) * D + n] * pool_scale[gI * 64 + d];
#pragma unroll
                    for (int ci = 0; ci < 8; ++ci) a[ci] += w_pool[(size_t)((gI * 64 + c0 + ci) * 64) + d] * wv; }
                u32x4 w; w.x = pk2(a[0], a[1]); w.y = pk2(a[2], a[3]); w.z = pk2(a[4], a[5]); w.w = pk2(a[6], a[7]);
                *(u32x4*)(WUP + (size_t)n * D + gI * 64 + c0) = w;
                continue; } r -= I_WP;
            if (r < I_IN + I_UA + I_UM + I_WO + I_FU + I_FD) {
                const float* W; int N, ldt = D, koff = 0, ro = 0, kb, nb; bf16_t* WT; const float* ks = nullptr;
                if (r < I_IN) { kb = r / 160; nb = r % 160; const int n0 = 32 * nb;
                    ro = (n0 < 1280) ? 0 : (n0 < 1792) ? (4608 - 1280) : -512; W = w_in; N = NIN; WT = WIN; }
                else if ((r -= I_IN) < I_UA) { kb = r / 32; nb = r % 32; W = w_up_attn; N = D; WT = WUP; koff = 256; }
                else if ((r -= I_UA) < I_UM) { kb = r / 32; nb = r % 32; W = w_up_mem; N = D; WT = WUP; koff = 768; }
                else if ((r -= I_UM) < I_WO) { kb = r / 32; nb = r % 32; W = w_out; N = D; WT = WOUT; }
                else if ((r -= I_WO) < I_FU) { kb = r / 176; nb = r % 176; W = w_ffn_up; N = 2 * DFF; WT = WFUP; ks = g_ffn; }
                else { r -= I_FU; kb = r / 32; nb = r % 32; W = w_ffn_down; N = D; WT = WDN; ldt = DFF; }
                transpose_item(W, N, WT, ldt, koff, ro, ks, scr, kb, nb, lane); continue; }
            r -= I_IN + I_UA + I_UM + I_WO + I_FU + I_FD;
            {
                const f32x4* xr = (const f32x4*)(x + (size_t)(2 * r) * D) + lane; const f32x4* gr = (const f32x4*)g_mix + lane;
                f32x4 v[8]; float s0 = 0.f, s1 = 0.f;
#pragma unroll
                for (int j = 0; j < 8; ++j) v[j] = xr[64 * j];
#pragma unroll
                for (int j = 0; j < 4; ++j) { s0 += (v[j][0] * v[j][0] + v[j][1] * v[j][1]) + (v[j][2] * v[j][2] + v[j][3] * v[j][3]);
                    s1 += (v[4 + j][0] * v[4 + j][0] + v[4 + j][1] * v[4 + j][1]) + (v[4 + j][2] * v[4 + j][2] + v[4 + j][3] * v[4 + j][3]); }
                const float rstd0 = __builtin_amdgcn_rsqf(wave_sum(s0) * (1.f / D) + EPS), rstd1 = __builtin_amdgcn_rsqf(wave_sum(s1) * (1.f / D) + EPS);
                u32x2* o8 = (u32x2*)(R1 + (size_t)(2 * r) * D) + lane;
#pragma unroll
                for (int j = 0; j < 8; ++j) { const f32x4 gg = gr[64 * (j & 3)]; const float rs = (j < 4) ? rstd0 : rstd1;
                    u32x2 w; w.x = pk2(v[j][0] * rs * gg[0], v[j][1] * rs * gg[1]); w.y = pk2(v[j][2] * rs * gg[2], v[j][3] * rs * gg[3]); o8[64 * j] = w; }
            }
        }
    }
    PH_T1(0);
    SEAM(0);
#ifdef DIAG
    unsigned* dg = (unsigned*)(ws + WS_BAR + 16384);
    if (bx == 0) { const int tid = wave * 64 + lane_id_v(); const unsigned h = hsh(tid * 7 + 1);
        { const int n = h % NIN, k = (h >> 13) % D; const int np = (n < 1280) ? n : (n < 1792) ? n + 3328 : n - 512; DCHK(11, bfv(WIN + (size_t)np * D + k), w_in[(size_t)k * NIN + n], 0.01f, 1e-4f); }
        { const int n = h % D, k = (h >> 13) % 512; DCHK(12, bfv(WUP + (size_t)n * D + 256 + k), w_up_attn[(size_t)k * D + n], 0.01f, 1e-4f); }
        { const int n = h % D, k = (h >> 13) % 256; DCHK(13, bfv(WUP + (size_t)n * D + 768 + k), w_up_mem[(size_t)k * D + n], 0.01f, 1e-4f); }
        { const int n = h % D, gc = (h >> 13) % 256, gI = gc >> 6; float e = 0.f; for (int d = 0; d < 64; ++d) e += w_pool[(size_t)gc * 64 + d] * pool_scale[gI * 64 + d] * w_up_pool[(size_t)(gI * 64 + d) * D + n];
          DCHK(14, bfv(WUP + (size_t)n * D + gc), e, 0.01f, 1e-3f); }
        { const int n = h % D, k = (h >> 13) % D; DCHK(15, bfv(WOUT + (size_t)n * D + k), w_out[(size_t)k * D + n], 0.01f, 1e-4f); }
        { const int n = h % (2 * DFF), k = (h >> 13) % D; DCHK(16, bfv(WFUP + (size_t)n * D + k), w_ffn_up[(size_t)k * 2 * DFF + n] * g_ffn[k], 0.01f, 1e-4f); }
        { const int n = h % D, k = (h >> 13) % DFF; DCHK(17, bfv(WDN + (size_t)n * DFF + k), w_ffn_down[(size_t)k * D + n], 0.01f, 1e-4f); }
        { const int m = h % 256, n = (h >> 13) % 512; float ss = 0.f, e = 0.f; for (int k = 0; k < D; ++k) { const float a = mem[(size_t)m * D + k]; ss += a * a; e += a * g_mem[k] * w_mem_kv[(size_t)k * 512 + n]; }
          e *= 1.f / sqrtf(ss / D + EPS); const float got = (n < 256) ? bfv(KM + kf_elem(8, n >> 6, m, n & 63)) : bfv(VMT + vf_elem(8, (n - 256) >> 6, m, (n - 256) & 63)); DCHK(18, got, e, 0.02f, 5e-3f); }
        { const int r = srow(tid), c = (h >> 7) % D; float ss = 0.f; for (int k = 0; k < D; ++k) { const float a = x[(size_t)r * D + k]; ss += a * a; }
          DCHK(19, bfv(R1 + (size_t)r * D + c), x[(size_t)r * D + c] / sqrtf(ss / D + EPS) * g_mix[c], 0.01f, 1e-3f); }
        if (tid < 1024) DCHK(10, bfv(R1 - 2 * D + tid) + bfv(R1 - 2 * D + tid + 512) + bfv(R1 - 2 * D + tid + 1024) + bfv(R1 - 2 * D + tid + 1536), 0.f, 0.f, 0.f);
    }
    GBAR();
#endif
    PH_T0(1);
    for (int rep = 0; rep < REP(1); ++rep) if (IN(1)) {
        { pg8::Gemm g{R1, WIN, D, (size_t)256 * D * 2, (size_t)128 * D * 2, (size_t)256 * D * 2, (size_t)128 * D * 2};
          pg8::StaticOrder So; So.init(S / 256, 18, G, bx); EpiIn E{QKU, GATES, b_gate, KFb};
          pg8::gemm_phase<EpiIn, pg8::StaticOrder>(lds, g, So, E, wave); }
        { pg8::Gemm g{WIN + (size_t)4608 * D, R1, D, (size_t)256 * D * 2, (size_t)128 * D * 2, (size_t)256 * D * 2, (size_t)128 * D * 2};
          pg8::StaticOrder So; So.init(2, S / 256, G, (bx + G / 2) % G); EpiVT E{VTb};
          pg8::gemm_phase<EpiVT, pg8::StaticOrder>(lds, g, So, E, wave); }
    }
    PH_T1(1);
    SEAM(1);
#ifdef DIAG
    if (bx == 0) { const int tid = wave * 64 + lane_id_v(); const unsigned h = hsh(tid * 11 + 3); const int r = srow(tid);
        { const int c = h % 4608; float e = dotbb(R1 + (size_t)r * D, WIN + (size_t)c * D, D);
          if (c < 1536) { if ((c >= 256 && c < 768) || c >= 1280) e *= QSCALE; const float got = (c >= 768 && c < 1280) ? bfv(KFb + kf_elem(512, (c - 768) >> 6, r, (c - 768) & 63)) : bfv(QKU + (size_t)r * QKU_P + c); DCHK(21 + (c >= 256) + (c >= 768) + (c >= 1280), got, e, 0.02f, 0.02f); }
          else { e = 1.f / (1.f + expf(-(e + b_gate[c - 1536]))); DCHK(25, bfv(GATES + (size_t)r * GATE_P + c - 1536), e, 0.02f, 0.01f); } }
        { const int c = h % 512; const float e = dotbb(R1 + (size_t)r * D, WIN + (size_t)(4608 + c) * D, D); DCHK(26, bfv(VTb + vf_elem(512, c >> 6, r, c & 63)), e, 0.02f, 0.02f); }
    }
    GBAR();
#endif
    PH_T0(2);
    for (int rep = 0; rep < REP(2); ++rep) if (IN(2)) {
        const int lane = lane_id_v(), tid = wave * 64 + lane;
        LAS float* bl = (LAS float*)(lds + LDS_BIAS);
        for (int i = tid; i < 8 * 321; i += 512) { const int hh = i / 321, j = i % 321; bl[i] = rel_bias[hh * 257 + (j > 256 ? 256 : j)] * LOG2E; }
        __syncthreads();
        bf16_t* OCAT = R1;
        for (int c = vcu; c < S / 64; c += G) {
            { const int jtmin = (c >= 8) ? 0 : 8 - c; const int tok0 = 64 * (c - 8 + jtmin);
              attn_wave(QKU + (size_t)64 * c * QKU_P + 256 + 64 * wave, QKU_P, KFb + kf_elem(512, wave, tok0, 0), VTb + vf_elem(512, wave, tok0, 0),
                        2 * (9 - jtmin), jtmin, bl + wave * 321, true, OCAT + (size_t)64 * c * D + 256 + 64 * wave, D, lane, lds + wave * 8192); }
            if (wave < 4) {
                attn_wave(QKU + (size_t)64 * c * QKU_P + 1280 + 64 * wave, QKU_P, KM + kf_elem(8, wave, 0, 0), VMT + vf_elem(8, wave, 0, 0), 8, 0,
                          bl, false, OCAT + (size_t)64 * c * D + 768 + 64 * wave, D, lane, lds + wave * 8192);
            } else {
                const int gI = wave - 4, ch = gI * 64 + (lane & 7) * 8, t0 = 64 * c + (lane >> 3) * 8;
                const bf16_t* U = QKU + ch; bf16_t* OC = OCAT + ch;
                if (gI == 0) pool_lane<2>(U, OC, t0); else if (gI == 1) pool_lane<4>(U, OC, t0); else if (gI == 2) pool_lane<8>(U, OC, t0); else pool_lane<16>(U, OC, t0);
            }
        }
    }
    PH_T1(2);
    SEAM(2);
#ifdef DIAG
    if (bx == 0) { const int tid = wave * 64 + lane_id_v(); const unsigned h = hsh(tid * 13 + 5); const int t = srow(tid);
        { const int ch = h % 256, gI = ch >> 6, win = 2 << gI; float sm = 0.f; for (int i = 0; i < win; ++i) if (t - i >= 0) sm += bfv(QKU + (size_t)(t - i) * QKU_P + ch);
          const float e = sm / (float)((t + 1 < win) ? t + 1 : win) - bfv(QKU + (size_t)t * QKU_P + ch); DCHK(31, bfv(R1 + (size_t)t * D + ch), e, 0.02f, 0.02f); }
        { const int hh = (h >> 8) % 8, d = (h >> 12) % 64, c = t >> 6; float mx = -1e30f, den = 0.f, num = 0.f;
          for (int pass = 0; pass < 2; ++pass) for (int j = 0; j < 576; ++j) { const int kt = 64 * (c - 8) + j; if (kt < 0) continue;
              float sc = 0.f; for (int dd = 0; dd < 64; ++dd) sc += bfv(QKU + (size_t)t * QKU_P + 256 + 64 * hh + dd) * bfv(KFb + kf_elem(512, hh, kt, dd));
              int rel = t - kt; rel = rel > 128 ? 128 : (rel < -128 ? -128 : rel); sc += rel_bias[hh * 257 + rel + 128] * LOG2E;
              if (pass == 0) mx = fmaxf(mx, sc); else { const float p = exp2f(sc - mx); den += p; num += p * bfv(VTb + vf_elem(512, hh, kt, d)); } }
          DCHK(32, bfv(R1 + (size_t)t * D + 256 + 64 * hh + d), num / den, 0.03f, 0.01f); }
        { const int hh = (h >> 8) % 4, d = (h >> 12) % 64; float mx = -1e30f, den = 0.f, num = 0.f;
          for (int pass = 0; pass < 2; ++pass) for (int j = 0; j < 256; ++j) { float sc = 0.f; for (int dd = 0; dd < 64; ++dd) sc += bfv(QKU + (size_t)t * QKU_P + 1280 + 64 * hh + dd) * bfv(KM + kf_elem(8, hh, j, dd));
              if (pass == 0) mx = fmaxf(mx, sc); else { const float p = exp2f(sc - mx); den += p; num += p * bfv(VMT + vf_elem(8, hh, j, d)); } }
          DCHK(33, bfv(R1 + (size_t)t * D + 768 + 64 * hh + d), num / den, 0.03f, 0.01f); }
    }
    GBAR();
#endif
    PH_T0(3);
    for (int rep = 0; rep < REP(3); ++rep) if (IN(3)) {
        pg8::Gemm g{R1, WUP, D, (size_t)256 * D * 2, (size_t)128 * D * 2, (size_t)256 * D * 2, (size_t)128 * D * 2};
        pg8::StaticOrder So; So.init(S / 256, 4, G, bx); EpiMerge E{GATES, MERGED};
        pg8::gemm_phase<EpiMerge, pg8::StaticOrder>(lds, g, So, E, wave);
    }
    PH_T1(3);
    SEAM(3);
#ifdef DIAG
    if (bx == 0) { const int tid = wave * 64 + lane_id_v(); const unsigned h = hsh(tid * 17 + 7); const int r = srow(tid), c = h % D;
        const float y0 = dotbb(R1 + (size_t)r * D, WUP + (size_t)c * D, 256), y1 = dotbb(R1 + (size_t)r * D + 256, WUP + (size_t)c * D + 256, 512), y2 = dotbb(R1 + (size_t)r * D + 768, WUP + (size_t)c * D + 768, 256);
        const float e = bfv(GATES + (size_t)r * GATE_P + c) * y0 + bfv(GATES + (size_t)r * GATE_P + D + c) * y1 + bfv(GATES + (size_t)r * GATE_P + 2 * D + c) * y2;
        DCHK(41, bfv(MERGED + (size_t)r * D + c), e, 0.03f, 0.02f); }
    GBAR();
#endif
    PH_T0(4);
    for (int rep = 0; rep < REP(4); ++rep) if (IN(4)) {
        pg8::Gemm g{MERGED, WOUT, D, (size_t)256 * D * 2, (size_t)128 * D * 2, (size_t)256 * D * 2, (size_t)128 * D * 2};
        pg8::StaticOrder So; So.init(S / 256, 4, G, bx); EpiResid<false> E{x, R1, PART};
        pg8::gemm_phase<EpiResid<false>, pg8::StaticOrder>(lds, g, So, E, wave);
    }
    PH_T1(4);
    SEAM(4);
#ifdef DIAG
    if (bx == 0) { const int tid = wave * 64 + lane_id_v(); const unsigned h = hsh(tid * 19 + 9); const int r = srow(tid), c = h % D;
        const float e = x[(size_t)r * D + c] + dotbb(MERGED + (size_t)r * D, WOUT + (size_t)c * D, D);
        DCHK(52, bfv(R1 + (size_t)r * D + c), e, 0.02f, 0.02f);
        float ss = 0.f, ps = 0.f; for (int k = 0; k < D; ++k) { const float a = bfv(R1 + (size_t)r * D + k); ss += a * a; } for (int k = 0; k < 16; ++k) ps += PART[(size_t)r * 16 + k];
        DCHK(53, ps, ss, 0.01f, 0.f); }
    GBAR();
#endif
    PH_T0(5);
    for (int rep = 0; rep < REP(5); ++rep) if (IN(5)) {
        pg8::Gemm g{R1 - 2 * D, WFUP, D, (size_t)252 * D * 2, (size_t)4 * D * 2, (size_t)128 * D * 2, (size_t)DFF * D * 2};
        pg8::StaticOrder So; So.init(66, 22, G, bx);
        LAS float* RS = (LAS float*)(lds + LDS_BIAS);
        { const int tid5 = wave * 64 + lane_id_v(), slot = tid5 & 255; Unit uu;
          for (int i = tid5 >> 8; i < 8 && So.next(i, uu); i += 2) { const int row = 252 * uu.pm - 2 + 126 * (slot >> 7) + (slot & 127); float v = 0.f;
              if (row >= 0 && row < S) { const f32x4* p = (const f32x4*)(PART + (size_t)row * 16); const f32x4 t = (p[0] + p[1]) + (p[2] + p[3]);
                  v = __builtin_amdgcn_rsqf(((t[0] + t[1]) + (t[2] + t[3])) * (1.f / D) + EPS); }
              RS[i * 256 + slot] = v; }
          __syncthreads(); }
        EpiFfnUp E{ACT, RS, conv_w, conv_b, (bf16_t*)(ws + WS_DUMP)};
        pg8::gemm_phase<EpiFfnUp, pg8::StaticOrder>(lds, g, So, E, wave);
    }
    PH_T1(5);
    SEAM(5);
#ifdef DIAG
    if (bx == 0) { const int tid = wave * 64 + lane_id_v(); const unsigned h = hsh(tid * 23 + 11); const int t = srow(tid), j = h % DFF;
        float cg = conv_b[j], cv = conv_b[DFF + j];
        for (int k = 0; k < 3; ++k) { const int tt = t - 2 + k; if (tt < 0) continue; float ps = 0.f; for (int q = 0; q < 16; ++q) ps += PART[(size_t)tt * 16 + q];
            const float rstd = 1.f / sqrtf(ps / D + EPS);
            cg += conv_w[(size_t)k * 2 * DFF + j] * rstd * dotbb(R1 + (size_t)tt * D, WFUP + (size_t)j * D, D);
            cv += conv_w[(size_t)k * 2 * DFF + DFF + j] * rstd * dotbb(R1 + (size_t)tt * D, WFUP + (size_t)(DFF + j) * D, D); }
        const float e = 0.5f * cg * (1.f + erff(cg * 0.70710678f)) * cv;
        DCHK(61 + ((tid < 64) ? (tid & 7) : 8), bfv(ACT + (size_t)t * DFF + j), e, 0.03f, 0.03f); }
    GBAR();
#endif
    PH_T0(6);
    const bool fuse_final = (G == 256);
    if (IN(6)) {
        pg8::Gemm g{ACT, WDN, DFF, (size_t)256 * DFF * 2, (size_t)128 * DFF * 2, (size_t)256 * DFF * 2, (size_t)128 * DFF * 2};
        pg8::StaticOrder So; So.init(S / 256, 4, G, bx);
        if (fuse_final) { EpiFinal E{R1, out, PART2, barw + 4160, g_final, barw + XB_TMO};
            pg8::gemm_phase<EpiFinal, pg8::StaticOrder>(lds, g, So, E, wave); }
        else { EpiResid<true> E{nullptr, R1, PART2};
            pg8::gemm_phase<EpiResid<true>, pg8::StaticOrder>(lds, g, So, E, wave); }
    }
    PH_T1(6);
    if (!fuse_final) SEAM(6);
    PH_T0(7);
    if (IN(7) && !fuse_final) {
        const int lane = lane_id_v();
        const int gw = vcu * NWAVES + wave, NGW = G * NWAVES;
        for (int r = gw; r < S; r += NGW) {
            const f32x4* p = (const f32x4*)(PART2 + (size_t)r * 16); const f32x4 t = (p[0] + p[1]) + (p[2] + p[3]);
            const float rstd = __builtin_amdgcn_rsqf(((t[0] + t[1]) + (t[2] + t[3])) * (1.f / D) + EPS);
            const u32x2* xr = (const u32x2*)(R1 + (size_t)r * D) + lane; const f32x4* gr = (const f32x4*)g_final + lane;
            f32x4* xw = (f32x4*)(out + (size_t)r * D) + lane;
#pragma unroll
            for (int j = 0; j < 4; ++j) { const u32x2 a = xr[64 * j]; const f32x4 v = {bflo(a.x), bfhi(a.x), bflo(a.y), bfhi(a.y)}; xw[64 * j] = v * gr[64 * j] * rstd; }
        }
    }
    PH_T1(7);
#ifdef DIAG
    GBAR();
    if (bx == 0 && wave == 0 && lane_id_v() == 0) { const unsigned code = __hip_atomic_load(dg, __ATOMIC_RELAXED, __HIP_MEMORY_SCOPE_AGENT); if (code != 0x7fffffffu) out[0] = 100.f * (float)code; }
#endif
#ifndef DIAG
    if (lo == 0 && hi > 1 && bx == 0 && wave == 0) { if (lane_id_v() == 0) (void)__hip_atomic_exchange(barw + 12288, 0u, __ATOMIC_RELAXED, __HIP_MEMORY_SCOPE_AGENT); }
#endif
#undef IN
#undef SEAM
}

#ifndef N_LAUNCHES
#define N_LAUNCHES 1
#endif
extern "C" void kernel_launch(void* const* d_in, const int* in_sizes, int n_in, void* d_out, int out_size, void* d_ws, size_t ws_size, hipStream_t stream) {
    static int grid = 0;
    if (grid == 0) {
        if (n_in != 20 || out_size != S * D || ws_size < WS_END) { fprintf(stderr, "kernel_launch: unexpected shapes (n_in %d out %d ws %zu)\n", n_in, out_size, ws_size); grid = -1; return; }
        int dev = 0, cus = 0, per_cu = 0;
        hipGetDevice(&dev); hipDeviceGetAttribute(&cus, hipDeviceAttributeMultiprocessorCount, dev);
        if (hipFuncSetAttribute((const void*)fwd_kernel, hipFuncAttributeMaxDynamicSharedMemorySize, LDS_BYTES) != hipSuccess) { fprintf(stderr, "kernel_launch: hipFuncSetAttribute failed\n"); grid = -1; return; }
        if (hipOccupancyMaxActiveBlocksPerMultiprocessor(&per_cu, (const void*)fwd_kernel, NWAVES * 64, LDS_BYTES) != hipSuccess || per_cu < 1) per_cu = 1;
        (void)hipGetLastError();
        grid = cus * per_cu; if (grid > 256) grid = 256;
        fprintf(stderr, "kernel_launch: grid %d (cus %d per_cu %d)\n", grid, cus, per_cu);
    }
    if (grid < 0) return;
    Args a{};
    for (int i = 0; i < 20; ++i) a.in[i] = (const float*)d_in[i];
    a.out = (float*)d_out; a.ws = (unsigned char*)d_ws;
#if N_LAUNCHES == 1
    a.ph_lo = 0; a.ph_hi = 8;
    void* kargs[] = {&a};
    hipError_t e = hipLaunchCooperativeKernel((const void*)fwd_kernel, dim3(grid), dim3(NWAVES * 64), kargs, LDS_BYTES, stream);
    if (e != hipSuccess) fprintf(stderr, "cooperative launch failed: %s (grid %d)\n", hipGetErrorString(e), grid);
#else
    for (int p = 0; p < 8; ++p) { a.ph_lo = p; a.ph_hi = p + 1; hipLaunchKernelGGL(fwd_kernel, dim3(grid), dim3(NWAVES * 64), LDS_BYTES, stream, a); }
#endif
}
```

```cpp
#include <hip/hip_runtime.h>
#include <hip/hip_cooperative_groups.h>
#include <cstdio>
#include <cstdint>
namespace cg = cooperative_groups;

#define DI __device__ __forceinline__
#define LAS __attribute__((address_space(3)))
typedef unsigned short bf16_t;
typedef short bf16x8 __attribute__((ext_vector_type(8)));
typedef short s16x4 __attribute__((ext_vector_type(4)));
typedef float f32x2 __attribute__((ext_vector_type(2)));
typedef float f32x4 __attribute__((ext_vector_type(4)));
typedef float f32x16 __attribute__((ext_vector_type(16)));
typedef unsigned u32x2 __attribute__((ext_vector_type(2)));
typedef unsigned u32x4 __attribute__((ext_vector_type(4)));
typedef __bf16 bf16x2_t __attribute__((ext_vector_type(2)));

constexpr int S = 16384, D = 1024, DFF = 2816, NIN = 5120, NWAVES = 8;
constexpr float EPS = 1e-6f, LOG2E = 1.4426950408889634f, QSCALE = 0.125f * LOG2E;
constexpr int QKU_P = 1536, GATE_P = 3072;
constexpr size_t MiB = 1u << 20;
constexpr size_t WS_WIN = 0, WS_WUP = 10 * MiB, WS_WOUT = 12 * MiB, WS_WFUP = 14 * MiB, WS_WDN = 25 * MiB;
constexpr size_t WS_KM = 31 * MiB, WS_VMT = WS_KM + 131072, WS_PART = WS_VMT + 131072, WS_PART2 = WS_PART + MiB;
constexpr size_t WS_BAR = WS_PART2 + MiB;
constexpr size_t WS_R1 = 34 * MiB;
constexpr size_t WS_QKU = 67 * MiB, WS_GATES = 115 * MiB, WS_VT = 211 * MiB, WS_KF = 227 * MiB, WS_END = 245 * MiB;
constexpr size_t WS_MERGED = WS_QKU, WS_ACT = WS_QKU, WS_DUMP = 244 * MiB;
constexpr int LDS_RING = 131072, LDS_BIAS = LDS_RING, LDS_MISC = LDS_BIAS + 10496, LDS_BYTES = 147456;

DI unsigned pk2(float lo, float hi) { f32x2 v = {lo, hi}; bf16x2_t b = __builtin_convertvector(v, bf16x2_t); return __builtin_bit_cast(unsigned, b); }
DI float bflo(unsigned u) { return __builtin_bit_cast(float, u << 16); }
DI float bfhi(unsigned u) { return __builtin_bit_cast(float, u & 0xffff0000u); }
DI float wave_sum(float v) {
#pragma unroll
    for (int o = 1; o < 64; o <<= 1) v += __shfl_xor(v, o);
    return v;
}
DI unsigned long long rt_v() { unsigned long long t; asm volatile("s_memrealtime %0\n\ts_waitcnt lgkmcnt(0)" : "=s"(t) :: "memory"); return t; }
DI int lane_id_v() { int l; asm volatile("v_mbcnt_lo_u32_b32 %0, -1, 0\n\tv_mbcnt_hi_u32_b32 %0, -1, %0" : "=v"(l)); return l; }
DI float dpp_shr1(float v) { float r; asm volatile("s_nop 1\n\tv_mov_b32_dpp %0, %1 row_shr:1 row_mask:0xf bank_mask:0xf bound_ctrl:1\n\ts_nop 1" : "=&v"(r) : "v"(v)); return r; }
DI void half_swap(float& a, float& b) { asm volatile("s_nop 1\n\tv_permlane32_swap_b32 %0, %1\n\ts_nop 1" : "+v"(a), "+v"(b)); }
DI float xhalf_max(float m) { float a = m, b = m; half_swap(a, b); return fmaxf(a, b); }
DI float xhalf_sum(float m) { float a = m, b = m; half_swap(a, b); return a + b; }
DI f32x2 gelu_pk(f32x2 v) {
    const f32x2 av = __builtin_elementwise_abs(v), d = av * 0.2316418882f + 1.0f;
    f32x2 t; t.x = __builtin_amdgcn_rcpf(d.x); t.y = __builtin_amdgcn_rcpf(d.y);
    f32x2 q = t * 0.5307027145f + (-0.7265760135f); q = q * t + 0.7107068705f; q = q * t + (-0.142248368f); q = q * t + 0.127414796f; q = q * t;
    const f32x2 s = (v * v) * (-0.72134752044f);
    f32x2 e; e.x = __builtin_amdgcn_exp2f(s.x); e.y = __builtin_amdgcn_exp2f(s.y);
    const f32x2 m = v * (q * e), r = v - m;
    f32x2 o; o.x = v.x < 0.f ? m.x : r.x; o.y = v.y < 0.f ? m.y : r.y; return o;
}

namespace pg8 {
constexpr int BM = 256, BK = 64, HALF = 128, HTB = HALF * BK * 2, NXCD = 8, WGM = 8;
DI int lds_byte(int r, int c) { const int st = (r >> 4) * 2 + (c >> 5), rr = r & 15, cc = c & 31, ob = rr * 64 + cc * 2; return st * 1024 + (ob ^ (((ob >> 9) & 1) << 5)); }
DI void stage_rc(int b, int& R, int& C) { const int st = b / 1024, sb = b % 1024, swz = sb ^ (((sb >> 9) & 1) << 5); R = (st >> 1) * 16 + swz / 64; C = (st & 1) * 32 + (swz % 64) / 2; }
DI int perm32(int rho) { const int n = rho >> 4, i = rho & 15; return 8 * (i >> 2) + 4 * n + (i & 3); }
struct Unit { int pm, pn, idx; };
struct Gemm { const bf16_t* A; const bf16_t* Bt; int K; size_t a_tstep, a_hstep, b_tstep, b_hstep; };
struct StaticOrder {
    int nM, nN, nwg, G, c;
    DI void init(int nM_, int nN_, int G_, int c_) { nM = nM_; nN = nN_; nwg = nM * nN; G = G_; c = c_; }
    DI bool next(int i, Unit& u) const {
        const long L = (long)i * G + c; if (L >= nwg) return false;
        int wgid = (int)L; { const int q = nwg / NXCD, r = nwg % NXCD, xcd = wgid % NXCD, off = wgid / NXCD; wgid = (xcd < r ? xcd * (q + 1) : r * (q + 1) + (xcd - r) * q) + off; }
        const int nig = WGM * nN, gid = wgid / nig, fm = gid * WGM, gsz = (nM - fm) < WGM ? (nM - fm) : WGM;
        u.pm = fm + ((wgid % nig) % gsz); u.pn = (wgid % nig) / gsz; u.idx = i; return true;
    }
};
template <class Epi, class Sched>
DI void gemm_phase(LAS unsigned char* lds, const Gemm g, const Sched& S, const Epi& E, const int wid) {
    const int lane = lane_id_v();
    const int tid = wid * 64 + lane, wr = wid >> 2, wc = wid & 3, fr = lane & 15, fq = lane >> 4;
    const int K = g.K, nt = K / BK;
    unsigned voffA[2], voffB[2];
#pragma unroll
    for (int i = 0; i < 2; ++i) { int R, C; stage_rc(tid * 16 + i * 8192, R, C); const int Rb = (R & ~31) + perm32(R & 31);
        const int Ra = Epi::ROWPERM ? (126 * (R >> 6) + 8 * (R & 15) + ((R >> 4) & 3)) : R;
        voffA[i] = (unsigned)(Ra * K + C) * 2u; voffB[i] = (unsigned)(Rb * K + C) * 2u; }
    const size_t kstep = (size_t)(BK * 2);
    const size_t hstepA = g.a_hstep, hstepB = g.b_hstep;
    const unsigned ldsw = (unsigned)wid * 1024u;
    const int aoff = lds_byte(wr * 64 + fr, fq * 8), boff = lds_byte(wc * 32 + fr, fq * 8);
#define PG8_SA(b, h) (((b) * 2 + (h)) * HTB)
#define PG8_SB(b, h) ((4 + (b) * 2 + (h)) * HTB)
#define PG8_STAGE(bufoff, gbase, voff) do { _Pragma("unroll") for (int _i = 0; _i < 2; ++_i) \
        __builtin_amdgcn_global_load_lds((const unsigned*)((const char*)(gbase) + (voff)[_i]), (LAS unsigned*)(lds + (bufoff) + ldsw + _i * 8192), 16, 0, 0); } while (0)
#define PG8_LDA(dst, b, h) do { _Pragma("unroll") for (int m = 0; m < 4; ++m) _Pragma("unroll") for (int k = 0; k < 2; ++k) dst[m][k] = *(const LAS bf16x8*)(lds + PG8_SA(b, h) + aoff + m * 2048 + k * 1024); } while (0)
#define PG8_LDB(dst, b, h) do { _Pragma("unroll") for (int n = 0; n < 2; ++n) _Pragma("unroll") for (int k = 0; k < 2; ++k) dst[n][k] = *(const LAS bf16x8*)(lds + PG8_SB(b, h) + boff + n * 2048 + k * 1024); } while (0)
#define PG8_MMA(ai, bj, At, Bt) do { __builtin_amdgcn_s_setprio(1); _Pragma("unroll") for (int m = 0; m < 4; ++m) _Pragma("unroll") for (int n = 0; n < 2; ++n) _Pragma("unroll") for (int k = 0; k < 2; ++k) \
        acc[ai][bj][m][n] = __builtin_amdgcn_mfma_f32_16x16x32_bf16(Bt[n][k], At[m][k], acc[ai][bj][m][n], 0, 0, 0); __builtin_amdgcn_s_setprio(0); } while (0)
#define PG8_WAIT_V(n) asm volatile("s_waitcnt vmcnt(" #n ")" ::: "memory")
#define PG8_WAIT_L(n) asm volatile("s_waitcnt lgkmcnt(" #n ")" ::: "memory")
#define PG8_BAR __builtin_amdgcn_s_barrier()
#define PG8_SCHED __builtin_amdgcn_sched_barrier(0)
    Unit cur, nxt; int ui = 0;
    if (!S.next(0, cur)) return;
    f32x4 acc[2][2][4][2];
#pragma unroll
    for (int a = 0; a < 2; ++a)
#pragma unroll
        for (int b = 0; b < 2; ++b)
#pragma unroll
            for (int m = 0; m < 4; ++m)
#pragma unroll
                for (int n = 0; n < 2; ++n) acc[a][b][m][n] = (f32x4){0.f, 0.f, 0.f, 0.f};
    bf16x8 At[4][2], B0[2][2], B1[2][2];
    const char* cA = (const char*)g.A + (size_t)cur.pm * g.a_tstep; const char* cB = (const char*)g.Bt + (size_t)cur.pn * g.b_tstep;
    PG8_STAGE(PG8_SB(0, 0), cB, voffB); PG8_STAGE(PG8_SB(0, 1), cB + hstepB, voffB); PG8_STAGE(PG8_SA(0, 0), cA, voffA); PG8_STAGE(PG8_SA(0, 1), cA + hstepA, voffA);
    if (wr == 1) PG8_BAR;
    PG8_WAIT_V(2); PG8_BAR;
    PG8_STAGE(PG8_SB(1, 0), cB + kstep, voffB); PG8_STAGE(PG8_SA(1, 0), cA + kstep, voffA); PG8_STAGE(PG8_SB(1, 1), cB + hstepB + kstep, voffB);
    PG8_WAIT_V(6); PG8_BAR;
    for (;;) {
        const bool has_next = S.next(ui + 1, nxt);
        const char* nA = has_next ? (const char*)g.A + (size_t)nxt.pm * g.a_tstep : cA; const char* nB = has_next ? (const char*)g.Bt + (size_t)nxt.pn * g.b_tstep : cB;
        for (int t = 0; t < nt; t += 2) {
            const bool last = (t == nt - 2);
            const char* a1 = cA + (size_t)(t + 1) * kstep;
            const char* a2 = last ? nA : cA + (size_t)(t + 2) * kstep; const char* b2 = last ? nB : cB + (size_t)(t + 2) * kstep;
            const char* a3 = a2 + kstep; const char* b3 = b2 + kstep;
            if constexpr (Epi::HOOK) { if (t == 4 || t == 12) {
                    if (wr == 0) PG8_BAR; E.hook(acc, cur, t, wr, wc, fr, fq); if (wr == 1) PG8_BAR; } }
            PG8_LDB(B0, 0, 0); PG8_LDB(B1, 0, 1); PG8_SCHED; PG8_LDA(At, 0, 0); PG8_STAGE(PG8_SA(1, 1), a1 + hstepA, voffA);
            PG8_WAIT_V(8); PG8_WAIT_L(0); PG8_BAR; PG8_MMA(0, 0, At, B0); PG8_MMA(0, 1, At, B1); PG8_BAR; PG8_SCHED;
            PG8_LDA(At, 0, 1); PG8_STAGE(PG8_SB(0, 0), b2, voffB); PG8_STAGE(PG8_SB(0, 1), b2 + hstepB, voffB); PG8_STAGE(PG8_SA(0, 0), a2, voffA);
            PG8_WAIT_V(8); PG8_WAIT_L(0); PG8_BAR; PG8_MMA(1, 0, At, B0); PG8_MMA(1, 1, At, B1); PG8_BAR; PG8_SCHED;
            PG8_LDB(B0, 1, 0); PG8_LDB(B1, 1, 1); PG8_SCHED; PG8_LDA(At, 1, 0); PG8_STAGE(PG8_SA(0, 1), a2 + hstepA, voffA);
            PG8_WAIT_V(8); PG8_WAIT_L(0); PG8_BAR; PG8_MMA(0, 0, At, B0); PG8_MMA(0, 1, At, B1); PG8_BAR; PG8_SCHED;
            PG8_LDA(At, 1, 1); PG8_STAGE(PG8_SB(1, 0), b3, voffB); PG8_STAGE(PG8_SB(1, 1), b3 + hstepB, voffB); PG8_STAGE(PG8_SA(1, 0), a3, voffA);
            PG8_WAIT_V(8); PG8_WAIT_L(0); PG8_BAR; PG8_MMA(1, 0, At, B0); PG8_MMA(1, 1, At, B1); PG8_BAR; PG8_SCHED;
        }
        if (wr == 0) PG8_BAR;
        E(acc, cur, wr, wc, fr, fq);
        if (!has_next) break;
#pragma unroll
        for (int a = 0; a < 2; ++a)
#pragma unroll
            for (int b = 0; b < 2; ++b)
#pragma unroll
                for (int m = 0; m < 4; ++m)
#pragma unroll
                    for (int n = 0; n < 2; ++n) acc[a][b][m][n] = (f32x4){0.f, 0.f, 0.f, 0.f};
        cur = nxt; cA = nA; cB = nB; ++ui;
        if (wr == 1) PG8_BAR;
    }
    PG8_WAIT_V(0);
    PG8_BAR;
#undef PG8_SA
#undef PG8_SB
#undef PG8_STAGE
#undef PG8_LDA
#undef PG8_LDB
#undef PG8_MMA
#undef PG8_WAIT_V
#undef PG8_WAIT_L
#undef PG8_BAR
#undef PG8_SCHED
}
}
using pg8::Unit;
typedef f32x4 Acc[2][2][4][2];

DI u32x4 pack8(f32x4 a, f32x4 b) { u32x4 w; w.x = pk2(a[0], a[1]); w.y = pk2(a[2], a[3]); w.z = pk2(b[0], b[1]); w.w = pk2(b[2], b[3]); return w; }
DI float sigmoidf_(float x) { return __builtin_amdgcn_rcpf(1.f + __builtin_amdgcn_exp2f(-x * LOG2E)); }


DI size_t kf_elem(int NB, int head, int tok, int d) { return ((((size_t)(head * NB + (tok >> 5)) * 4 + (d >> 4)) * 64 + ((d >> 3) & 1) * 32 + (tok & 31)) << 3) + (d & 7); }
DI size_t vf_elem(int NB, int head, int tok, int d) { const int t = tok & 31; return (((((size_t)(head * NB + (tok >> 5)) * 2 + (d >> 5)) * 4 + (t >> 3)) * 64 + ((t >> 2) & 1) * 32 + (d & 31)) << 2) + (t & 3); }

struct EpiIn {
    static constexpr bool HOOK = false, ROWPERM = false;
    bf16_t* QKU; bf16_t* GATES; const float* b_gate; bf16_t* KF;
    DI void operator()(const Acc& acc, const Unit& u, int wr, int wc, int fr, int fq) const {
        const int row0 = u.pm * 256 + wr * 64 + fr, pn = u.pn;
        if (pn == 3 || pn == 4) {
#pragma unroll
            for (int ai = 0; ai < 2; ++ai)
#pragma unroll
                for (int m = 0; m < 4; ++m)
#pragma unroll
                    for (int bj = 0; bj < 2; ++bj) { const int tok = row0 + ai * 128 + m * 16, c = (pn - 3) * 256 + bj * 128 + wc * 32 + 8 * fq;
                        *(u32x4*)(KF + kf_elem(512, c >> 6, tok, c & 63)) = pack8(acc[ai][bj][m][0], acc[ai][bj][m][1]); }
            return; }
        if (pn >= 6) {
            const int col0 = (pn - 6) * 256 + wc * 32 + 8 * fq;
            f32x4 bv[2][2];
#pragma unroll
            for (int bj = 0; bj < 2; ++bj)
#pragma unroll
                for (int n = 0; n < 2; ++n) bv[bj][n] = *(const f32x4*)(b_gate + col0 + bj * 128 + 4 * n);
#pragma unroll
            for (int ai = 0; ai < 2; ++ai)
#pragma unroll
                for (int m = 0; m < 4; ++m) { bf16_t* rowp = GATES + (size_t)(row0 + ai * 128 + m * 16) * GATE_P + col0;
#pragma unroll
                    for (int bj = 0; bj < 2; ++bj) { f32x4 v0 = acc[ai][bj][m][0] + bv[bj][0], v1 = acc[ai][bj][m][1] + bv[bj][1];
#pragma unroll
                        for (int j = 0; j < 4; ++j) { v0[j] = fmaxf(sigmoidf_(v0[j]), 1e-9f); v1[j] = fmaxf(sigmoidf_(v1[j]), 1e-9f); }
                        *(u32x4*)(rowp + bj * 128) = pack8(v0, v1); } }
            return; }
        const float sc = (pn == 1 || pn == 2 || pn == 5) ? QSCALE : 1.f;
        const int col0 = pn * 256 + wc * 32 + 8 * fq;
#pragma unroll
        for (int ai = 0; ai < 2; ++ai)
#pragma unroll
            for (int m = 0; m < 4; ++m) { bf16_t* rowp = QKU + (size_t)(row0 + ai * 128 + m * 16) * QKU_P + col0;
#pragma unroll
                for (int bj = 0; bj < 2; ++bj) *(u32x4*)(rowp + bj * 128) = pack8(acc[ai][bj][m][0] * sc, acc[ai][bj][m][1] * sc); }
    }
};
struct EpiVT {
    static constexpr bool HOOK = false, ROWPERM = false;
    bf16_t* VF;
    DI void operator()(const Acc& acc, const Unit& u, int wr, int wc, int fr, int fq) const {
        const int row0 = u.pm * 256 + wr * 64 + fr, col0 = u.pn * 256 + wc * 32 + 8 * fq;
#pragma unroll
        for (int ai = 0; ai < 2; ++ai)
#pragma unroll
            for (int m = 0; m < 4; ++m) { const int hd = row0 + ai * 128 + m * 16;
#pragma unroll
                for (int bj = 0; bj < 2; ++bj) { const int tok = col0 + bj * 128;
                    u32x2 w0, w1; w0.x = pk2(acc[ai][bj][m][0][0], acc[ai][bj][m][0][1]); w0.y = pk2(acc[ai][bj][m][0][2], acc[ai][bj][m][0][3]);
                    w1.x = pk2(acc[ai][bj][m][1][0], acc[ai][bj][m][1][1]); w1.y = pk2(acc[ai][bj][m][1][2], acc[ai][bj][m][1][3]);
                    *(u32x2*)(VF + vf_elem(512, hd >> 6, tok, hd & 63)) = w0; *(u32x2*)(VF + vf_elem(512, hd >> 6, tok + 4, hd & 63)) = w1; } }
    }
};
struct EpiMerge {
    static constexpr bool HOOK = true, ROWPERM = false;
    const bf16_t* GATES; bf16_t* MERGED;
    DI void hook(Acc& acc, const Unit& u, int t, int wr, int wc, int fr, int fq) const {
        int row0 = u.pm * 256 + wr * 64 + fr; const int col0 = u.pn * 256 + wc * 32 + 8 * fq;
        asm volatile("" : "+v"(row0));
        const int ga = (t == 4) ? 0 : D, gb = ga + D;
#pragma unroll
        for (int ai = 0; ai < 2; ++ai)
#pragma unroll
            for (int m = 0; m < 4; ++m) { const bf16_t* gp = GATES + (size_t)(row0 + ai * 128 + m * 16) * GATE_P + col0;
#pragma unroll
                for (int bj = 0; bj < 2; ++bj) { const u32x4 a = *(const u32x4*)(gp + ga + bj * 128), b = *(const u32x4*)(gp + gb + bj * 128);
                    f32x4 r0, r1;
                    r0[0] = bflo(a.x) * __builtin_amdgcn_rcpf(bflo(b.x)); r0[1] = bfhi(a.x) * __builtin_amdgcn_rcpf(bfhi(b.x));
                    r0[2] = bflo(a.y) * __builtin_amdgcn_rcpf(bflo(b.y)); r0[3] = bfhi(a.y) * __builtin_amdgcn_rcpf(bfhi(b.y));
                    r1[0] = bflo(a.z) * __builtin_amdgcn_rcpf(bflo(b.z)); r1[1] = bfhi(a.z) * __builtin_amdgcn_rcpf(bfhi(b.z));
                    r1[2] = bflo(a.w) * __builtin_amdgcn_rcpf(bflo(b.w)); r1[3] = bfhi(a.w) * __builtin_amdgcn_rcpf(bfhi(b.w));
                    acc[ai][bj][m][0] = acc[ai][bj][m][0] * r0; acc[ai][bj][m][1] = acc[ai][bj][m][1] * r1; } }
    }
    DI void operator()(const Acc& acc, const Unit& u, int wr, int wc, int fr, int fq) const {
        const int row0 = u.pm * 256 + wr * 64 + fr, col0 = u.pn * 256 + wc * 32 + 8 * fq;
#pragma unroll
        for (int ai = 0; ai < 2; ++ai)
#pragma unroll
            for (int m = 0; m < 4; ++m) { const size_t row = (size_t)(row0 + ai * 128 + m * 16);
#pragma unroll
                for (int bj = 0; bj < 2; ++bj) { const u32x4 a = *(const u32x4*)(GATES + row * GATE_P + 2 * D + col0 + bj * 128);
                    const f32x4 g0 = {bflo(a.x), bfhi(a.x), bflo(a.y), bfhi(a.y)}, g1 = {bflo(a.z), bfhi(a.z), bflo(a.w), bfhi(a.w)};
                    *(u32x4*)(MERGED + row * D + col0 + bj * 128) = pack8(acc[ai][bj][m][0] * g0, acc[ai][bj][m][1] * g1); } }
    }
};
template <bool IN_BF16>
struct EpiResid {
    static constexpr bool HOOK = false, ROWPERM = false;
    const float* XI; bf16_t* XB; float* PART;
    DI void operator()(const Acc& acc, const Unit& u, int wr, int wc, int fr, int fq) const {
        const int row0 = u.pm * 256 + wr * 64 + fr, col0 = u.pn * 256 + wc * 32 + 8 * fq;
#pragma unroll
        for (int ai = 0; ai < 2; ++ai) {
            f32x4 xin[4][2][2];
#pragma unroll
            for (int m = 0; m < 4; ++m)
#pragma unroll
                for (int bj = 0; bj < 2; ++bj) { const size_t off = (size_t)(row0 + ai * 128 + m * 16) * D + col0 + bj * 128;
                    if (IN_BF16) { const u32x4 a = *(const u32x4*)(XB + off); xin[m][bj][0] = (f32x4){bflo(a.x), bfhi(a.x), bflo(a.y), bfhi(a.y)}; xin[m][bj][1] = (f32x4){bflo(a.z), bfhi(a.z), bflo(a.w), bfhi(a.w)}; }
                    else { xin[m][bj][0] = *(const f32x4*)(XI + off); xin[m][bj][1] = *(const f32x4*)(XI + off + 4); } }
            __builtin_amdgcn_sched_barrier(0);
#pragma unroll
            for (int m = 0; m < 4; ++m) { const size_t row = (size_t)(row0 + ai * 128 + m * 16); float ss = 0.f;
#pragma unroll
                for (int bj = 0; bj < 2; ++bj) { const size_t off = row * D + col0 + bj * 128;
                    const f32x4 v0 = xin[m][bj][0] + acc[ai][bj][m][0], v1 = xin[m][bj][1] + acc[ai][bj][m][1];
                    *(u32x4*)(XB + off) = pack8(v0, v1);
                    ss += (v0[0] * v0[0] + v0[1] * v0[1]) + (v0[2] * v0[2] + v0[3] * v0[3]) + (v1[0] * v1[0] + v1[1] * v1[1]) + (v1[2] * v1[2] + v1[3] * v1[3]); }
                ss += __shfl_xor(ss, 16); ss += __shfl_xor(ss, 32);
                if (fq == 0) PART[row * 16 + u.pn * 4 + wc] = ss; }
        }
    }
};
struct EpiFfnUp {
    static constexpr bool HOOK = false, ROWPERM = true;
    bf16_t* ACT; const LAS float* RS; const float* conv_w; const float* conv_b; bf16_t* DUMP;
    DI void operator()(const Acc& acc, const Unit& u, int wr, int wc, int fr, int fq) const {
        const int r0 = 252 * u.pm - 2 + 126 * wr + 8 * fr;
        float rs[8];
        const LAS float* rsp = RS + (u.idx * 256 + wr * 128 + 8 * fr);
        { const f32x4 ra = *(const LAS f32x4*)rsp, rb = *(const LAS f32x4*)(rsp + 4); rs[0] = ra[0]; rs[1] = ra[1]; rs[2] = ra[2]; rs[3] = ra[3]; rs[4] = rb[0]; rs[5] = rb[1]; rs[6] = rb[2]; rs[7] = rb[3]; }
        const int j0 = 128 * u.pn + 32 * wc + 8 * fq;
#pragma unroll
        for (int n = 0; n < 2; ++n) {
            const int jc = j0 + 4 * n;
            const f32x4 wg0 = *(const f32x4*)(conv_w + jc), wg1 = *(const f32x4*)(conv_w + 2 * DFF + jc), wg2 = *(const f32x4*)(conv_w + 4 * DFF + jc), bg = *(const f32x4*)(conv_b + jc);
            const f32x4 wv0 = *(const f32x4*)(conv_w + DFF + jc), wv1 = *(const f32x4*)(conv_w + 3 * DFF + jc), wv2 = *(const f32x4*)(conv_w + 5 * DFF + jc), bv = *(const f32x4*)(conv_b + DFF + jc);
            f32x4 g[8], v[8];
#pragma unroll
            for (int i = 0; i < 8; ++i) { g[i] = acc[i >> 2][0][i & 3][n] * rs[i]; v[i] = acc[i >> 2][1][i & 3][n] * rs[i]; }
            f32x4 gp6, gp7, vp6, vp7;
#pragma unroll
            for (int j = 0; j < 4; ++j) {
                gp6[j] = dpp_shr1(g[6][j]);
                gp7[j] = dpp_shr1(g[7][j]);
                vp6[j] = dpp_shr1(v[6][j]);
                vp7[j] = dpp_shr1(v[7][j]); }
#pragma unroll
            for (int i = 7; i >= 0; --i) {
                const f32x4 gm1 = (i >= 1) ? g[i - 1] : gp7, gm2 = (i >= 2) ? g[i - 2] : (i == 1 ? gp7 : gp6);
                const f32x4 vm1 = (i >= 1) ? v[i - 1] : vp7, vm2 = (i >= 2) ? v[i - 2] : (i == 1 ? vp7 : vp6);
                const f32x4 cg = bg + wg2 * g[i] + wg1 * gm1 + wg0 * gm2;
                const f32x4 cv = bv + wv2 * v[i] + wv1 * vm1 + wv0 * vm2;
                const f32x2 ga = gelu_pk((f32x2){cg[0], cg[1]}), gb = gelu_pk((f32x2){cg[2], cg[3]});
                const int row = r0 + i;
                u32x2 w; w.x = pk2(ga.x * cv[0], ga.y * cv[1]); w.y = pk2(gb.x * cv[2], gb.y * cv[3]);
                bf16_t* dst = ((8 * fr + i >= 2) && row < S) ? ACT + (size_t)row * DFF + jc : DUMP + (((wr * 4 + wc) * 64 + fq * 16 + fr) << 2);
                *(u32x2*)dst = w;
            }
        }
    }
};

#define MFMA32(a, b, c) __builtin_amdgcn_mfma_f32_32x32x16_bf16((a), (b), (c), 0, 0, 0)
DI int crow(int i, int g) { return (i & 3) + 8 * (i >> 2) + 4 * g; }
DI void attn_step(bf16x8 (&kf)[4], const char* kbase, unsigned& koff, const s16x4 (&v0)[4], const s16x4 (&v1)[4], const LAS bf16x8* ql, f32x16 (&o)[2][2], float (&mrun)[2], float (&lrun)[2],
                  int it, int jt0, const LAS float* bias, bool has_bias, int r, int g) {
    f32x16 s[2];
#pragma unroll
    for (int qb = 0; qb < 2; ++qb)
#pragma unroll
        for (int i = 0; i < 16; ++i) s[qb][i] = 0.f;
#pragma unroll
    for (int st = 0; st < 4; ++st) {
        if ((st & 1) == 0) asm volatile("" ::: "memory");
#pragma unroll
        for (int qb = 0; qb < 2; ++qb) s[qb] = MFMA32(kf[st], ql[(qb * 4 + st) * 64], s[qb]);
    }
    koff += 4096u;
#pragma unroll
    for (int st = 0; st < 4; ++st) kf[st] = *(const bf16x8*)(kbase + koff + 1024 * st);
    if (has_bias) { const int jt = jt0 + (it >> 1);
        if (jt <= 5) { const float c = bias[256];
#pragma unroll
            for (int qb = 0; qb < 2; ++qb)
#pragma unroll
                for (int i = 0; i < 16; ++i) s[qb][i] += c;
        } else { const LAS float* bp = bias + (64 * (8 - jt) + 128 - 32 * (it & 1) + r - 4 * g - 27);
#pragma unroll
            for (int qb = 0; qb < 2; ++qb)
#pragma unroll
                for (int i = 0; i < 16; ++i) s[qb][i] += bp[27 + 32 * qb - ((i & 3) + 8 * (i >> 2))];
        } }
    float mn[2];
#pragma unroll
    for (int qb = 0; qb < 2; ++qb) {
        float m = fmaxf(fmaxf(s[qb][0], s[qb][1]), s[qb][2]);
#pragma unroll
        for (int i = 3; i < 15; i += 2) m = fmaxf(fmaxf(m, s[qb][i]), s[qb][i + 1]);
        m = fmaxf(m, s[qb][15]);
        mn[qb] = fmaxf(mrun[qb], xhalf_max(m));
    }
    if (__any((mn[0] > mrun[0]) || (mn[1] > mrun[1]))) {
#pragma unroll
        for (int qb = 0; qb < 2; ++qb) {
            const float al = __builtin_amdgcn_exp2f(mrun[qb] - mn[qb]); mrun[qb] = mn[qb];
            lrun[qb] *= al;
#pragma unroll
            for (int db = 0; db < 2; ++db)
#pragma unroll
                for (int i = 0; i < 16; ++i) o[db][qb][i] *= al;
        }
    }
#pragma unroll
    for (int qb = 0; qb < 2; ++qb) {
        float ls = 0.f;
#pragma unroll
        for (int i = 0; i < 16; ++i) { const float p = __builtin_amdgcn_exp2f(s[qb][i] - mn[qb]); s[qb][i] = p; ls += p; }
        lrun[qb] += ls;
    }
#pragma unroll
    for (int sp = 0; sp < 2; ++sp) {
        bf16x8 pf[2];
#pragma unroll
        for (int qb = 0; qb < 2; ++qb) { u32x4 w; w.x = pk2(s[qb][8 * sp + 0], s[qb][8 * sp + 1]); w.y = pk2(s[qb][8 * sp + 2], s[qb][8 * sp + 3]);
            w.z = pk2(s[qb][8 * sp + 4], s[qb][8 * sp + 5]); w.w = pk2(s[qb][8 * sp + 6], s[qb][8 * sp + 7]); pf[qb] = __builtin_bit_cast(bf16x8, w); }
        const bf16x8 vf0 = __builtin_shufflevector(v0[2 * sp], v0[2 * sp + 1], 0, 1, 2, 3, 4, 5, 6, 7);
        const bf16x8 vf1 = __builtin_shufflevector(v1[2 * sp], v1[2 * sp + 1], 0, 1, 2, 3, 4, 5, 6, 7);
#pragma unroll
        for (int qb = 0; qb < 2; ++qb) { o[0][qb] = MFMA32(vf0, pf[qb], o[0][qb]); o[1][qb] = MFMA32(vf1, pf[qb], o[1][qb]); }
    }
}
#define ATTN_LOADV(v0_, v1_) do { _Pragma("unroll") for (int j = 0; j < 4; ++j) { v0_[j] = *(const s16x4*)(vbase + voff + 512 * j); v1_[j] = *(const s16x4*)(vbase + voff + 2048 + 512 * j); } voff += 4096u; } while (0)
DI void attn_wave(const bf16_t* Q, int qp, const bf16_t* KFp, const bf16_t* VFp, int nsteps, int jt0,
                  const LAS float* bias, bool has_bias, bf16_t* O, int op, int lane_in, LAS unsigned char* qlds) {
    int lane = lane_in; asm volatile("" : "+v"(lane));
    const int r = lane & 31, g = lane >> 5;
    LAS bf16x8* ql = (LAS bf16x8*)qlds + lane;
#pragma unroll
    for (int qb = 0; qb < 2; ++qb)
#pragma unroll
        for (int st = 0; st < 4; ++st) ql[(qb * 4 + st) * 64] = *(const bf16x8*)(Q + (size_t)(32 * qb + r) * qp + 16 * st + 8 * g);
    f32x16 o[2][2]; float mrun[2] = {-1e30f, -1e30f}, lrun[2] = {0.f, 0.f};
#pragma unroll
    for (int a = 0; a < 2; ++a)
#pragma unroll
        for (int b = 0; b < 2; ++b)
#pragma unroll
            for (int i = 0; i < 16; ++i) o[a][b][i] = 0.f;
    const char* kbase = (const char*)KFp; const char* vbase = (const char*)VFp;
    unsigned koff = (unsigned)lane * 16u, voff = (unsigned)lane * 8u;
    bf16x8 kf[4]; s16x4 v0A[4], v1A[4], v0B[4], v1B[4];
#pragma unroll
    for (int st = 0; st < 4; ++st) kf[st] = *(const bf16x8*)(kbase + koff + 1024 * st);
    ATTN_LOADV(v0A, v1A);
    for (int it = 0; it < nsteps; it += 2) {
        ATTN_LOADV(v0B, v1B);
        attn_step(kf, kbase, koff, v0A, v1A, ql, o, mrun, lrun, it, jt0, bias, has_bias, r, g);
        ATTN_LOADV(v0A, v1A);
        attn_step(kf, kbase, koff, v0B, v1B, ql, o, mrun, lrun, it + 1, jt0, bias, has_bias, r, g);
    }
    int l2 = lane; asm volatile("" : "+v"(l2));
    const int r2 = l2 & 31, g2 = l2 >> 5;
#pragma unroll
    for (int qb = 0; qb < 2; ++qb) { const float inv = 1.f / xhalf_sum(lrun[qb]);
#pragma unroll
        for (int db = 0; db < 2; ++db)
#pragma unroll
            for (int ig = 0; ig < 4; ++ig) { u32x2 w; w.x = pk2(o[db][qb][4 * ig] * inv, o[db][qb][4 * ig + 1] * inv); w.y = pk2(o[db][qb][4 * ig + 2] * inv, o[db][qb][4 * ig + 3] * inv);
                *(u32x2*)(O + (size_t)(32 * qb + r2) * op + 32 * db + 8 * ig + 4 * g2) = w; } }
}

template <int WIN> DI void pool_lane(const bf16_t* U, bf16_t* OC, int t0) {
    u32x4 rows[WIN + 7];
#pragma unroll
    for (int j = 0; j < WIN + 7; ++j) { const int t = t0 - WIN + 1 + j; rows[j] = (t >= 0) ? *(const u32x4*)(U + (size_t)t * QKU_P) : (u32x4){0u, 0u, 0u, 0u}; }
    float sm[8];
#pragma unroll
    for (int c = 0; c < 8; ++c) sm[c] = 0.f;
#pragma unroll
    for (int j = 0; j < WIN; ++j) { const u32x4 a = rows[j];
        sm[0] += bflo(a.x); sm[1] += bfhi(a.x); sm[2] += bflo(a.y); sm[3] += bfhi(a.y); sm[4] += bflo(a.z); sm[5] += bfhi(a.z); sm[6] += bflo(a.w); sm[7] += bfhi(a.w); }
#pragma unroll
    for (int k = 0; k < 8; ++k) { const int t = t0 + k; const u32x4 a = rows[k + WIN - 1];
        if (k > 0) { const u32x4 b = rows[k - 1];
            sm[0] += bflo(a.x) - bflo(b.x); sm[1] += bfhi(a.x) - bfhi(b.x); sm[2] += bflo(a.y) - bflo(b.y); sm[3] += bfhi(a.y) - bfhi(b.y);
            sm[4] += bflo(a.z) - bflo(b.z); sm[5] += bfhi(a.z) - bfhi(b.z); sm[6] += bflo(a.w) - bflo(b.w); sm[7] += bfhi(a.w) - bfhi(b.w); }
        const float ic = 1.f / (float)((t + 1 < WIN) ? t + 1 : WIN);
        u32x4 w; w.x = pk2(sm[0] * ic - bflo(a.x), sm[1] * ic - bfhi(a.x)); w.y = pk2(sm[2] * ic - bflo(a.y), sm[3] * ic - bfhi(a.y));
        w.z = pk2(sm[4] * ic - bflo(a.z), sm[5] * ic - bfhi(a.z)); w.w = pk2(sm[6] * ic - bflo(a.w), sm[7] * ic - bfhi(a.w));
        *(u32x4*)(OC + (size_t)t * D) = w; }
}

DI void transpose_item(const float* W, int N, bf16_t* WT, int ldt, int koff, int row_off, const float* kscale, LAS float* scr, int kb, int nb, int lane) {
    const int k0 = 64 * kb, n0 = 32 * nb;
    const float* wp = W + (size_t)(k0 + (lane >> 5)) * N + n0 + (lane & 31);
    float v[32];
#pragma unroll
    for (int i = 0; i < 32; ++i) v[i] = __builtin_nontemporal_load(wp + (size_t)(2 * i) * N);
#pragma unroll
    for (int i = 0; i < 32; ++i) scr[(2 * i + (lane >> 5)) * 33 + (lane & 31)] = v[i];
    asm volatile("s_waitcnt lgkmcnt(0)" ::: "memory");
    const int c = lane & 7;
    float gs[8];
#pragma unroll
    for (int j = 0; j < 8; ++j) gs[j] = kscale ? kscale[k0 + 8 * c + j] : 1.f;
#pragma unroll
    for (int j = 0; j < 4; ++j) { const int n = (lane >> 3) + 8 * j; const LAS float* s = scr + (8 * c) * 33 + n;
        u32x4 o; o.x = pk2(s[0 * 33] * gs[0], s[1 * 33] * gs[1]); o.y = pk2(s[2 * 33] * gs[2], s[3 * 33] * gs[3]); o.z = pk2(s[4 * 33] * gs[4], s[5 * 33] * gs[5]); o.w = pk2(s[6 * 33] * gs[6], s[7 * 33] * gs[7]);
        *(u32x4*)(WT + (size_t)(row_off + n0 + n) * ldt + koff + k0 + 8 * c) = o; }
    asm volatile("s_waitcnt lgkmcnt(0)" ::: "memory");
}

#define XB_TMO      128
#define XB_XCNT(j)  (256  + 64 * (j))
#define XB_XSUB(j)  (1280 + 64 * (j))
#define XB_XGEN(j)  (2304 + 64 * (j))
#define XB_TOP      3328
#define XB_TOPGEN   3392
#define XCD_BAR_WORDS 3456
#define XB_SPIN_CAP (1u << 20)
DI unsigned xb_ld(unsigned* p)              { return __hip_atomic_load(p, __ATOMIC_RELAXED, __HIP_MEMORY_SCOPE_AGENT); }
DI unsigned xb_add(unsigned* p, unsigned v) { return __hip_atomic_fetch_add(p, v, __ATOMIC_RELAXED, __HIP_MEMORY_SCOPE_AGENT); }
DI unsigned xb_xcc_id() { return (unsigned)__builtin_amdgcn_s_getreg((3 << 11) | 20) & 0xFu; }
#define XB_SPIN(cond, bar) do { unsigned _sp = 0; while (cond) { __builtin_amdgcn_s_sleep(1); \
    if ((++_sp & 255u) == 0u) { if (xb_ld(&(bar)[XB_TMO])) break; if (_sp > XB_SPIN_CAP) { atomicAdd(&(bar)[XB_TMO], 1u); break; } } } } while (0)
DI void xcd_barrier_complete(unsigned* bar, unsigned x, unsigned G, unsigned& nloc, unsigned& nx) {
    unsigned sum, cnt, mine, sp = 0u;
    for (;;) {
        sum = 0u; cnt = 0u; mine = 0u;
#pragma unroll
        for (unsigned j = 0; j < 16; ++j) { const unsigned c = xb_ld(&bar[XB_XCNT(j)]); sum += c; cnt += (c > 0u) ? 1u : 0u; mine = (j == x) ? c : mine; }
        if (sum == G) break;
        __builtin_amdgcn_s_sleep(1);
        if ((++sp & 255u) == 0u) { if (xb_ld(&bar[XB_TMO])) break; if (sp > XB_SPIN_CAP) { atomicAdd(&bar[XB_TMO], 1u); break; } }
    }
    nloc = mine > 0u ? mine : 1u; nx = cnt > 0u ? cnt : 1u;
}
DI void grid_bar(unsigned* bar, volatile LAS unsigned* st, unsigned G, int wave) {
    asm volatile("s_waitcnt vmcnt(0)" ::: "memory");
    __syncthreads();
    if (wave == 0) { if (lane_id_v() == 0) {
        __builtin_amdgcn_s_waitcnt(0);
        const unsigned x = xb_xcc_id();
        unsigned nloc = st[0], nx = st[1];
        if (nloc == 0u) { xcd_barrier_complete(bar, x, G, nloc, nx); st[0] = nloc; st[1] = nx; }
        const unsigned old = xb_add(&bar[XB_XSUB(x)], 1u);
        const unsigned gen = old / nloc;
        if (old + 1u == (gen + 1u) * nloc) {
            __builtin_amdgcn_fence(__ATOMIC_RELEASE, "agent");
            asm volatile("s_waitcnt vmcnt(0)" ::: "memory");
            const unsigned og = xb_add(&bar[XB_TOP], 1u);
            const unsigned tg = og / nx;
            if (og + 1u == (tg + 1u) * nx) xb_add(&bar[XB_TOPGEN], 1u);
            else XB_SPIN(xb_ld(&bar[XB_TOPGEN]) == tg, bar);
            __builtin_amdgcn_fence(__ATOMIC_ACQUIRE, "agent");
            xb_add(&bar[XB_XGEN(x)], 1u);
            asm volatile("s_waitcnt vmcnt(0)" ::: "memory");
        } else {
            XB_SPIN(xb_ld(&bar[XB_XGEN(x)]) == gen, bar);
            __builtin_amdgcn_fence(__ATOMIC_ACQUIRE, "agent");
            asm volatile("s_waitcnt vmcnt(0)" ::: "memory");
        }
    } }
    __syncthreads();
}

struct EpiFinal {
    static constexpr bool HOOK = false, ROWPERM = false;
    const bf16_t* XB; float* OUT; float* PARTF; unsigned* CNT; const float* gfin; unsigned* tmo;
    DI void operator()(Acc& acc, const Unit& u, int wr, int wc, int fr, int fq) const {
        const int row0 = u.pm * 256 + wr * 64 + fr, col0 = u.pn * 256 + wc * 32 + 8 * fq;
        u32x4 xin[16];
#pragma unroll
        for (int ai = 0; ai < 2; ++ai)
#pragma unroll
            for (int m = 0; m < 4; ++m)
#pragma unroll
                for (int bj = 0; bj < 2; ++bj) xin[(ai * 4 + m) * 2 + bj] = *(const u32x4*)(XB + (size_t)(row0 + ai * 128 + m * 16) * D + col0 + bj * 128);
        __builtin_amdgcn_sched_barrier(0);
#pragma unroll
        for (int ai = 0; ai < 2; ++ai)
#pragma unroll
            for (int m = 0; m < 4; ++m) { const size_t row = (size_t)(row0 + ai * 128 + m * 16); float ss = 0.f;
#pragma unroll
                for (int bj = 0; bj < 2; ++bj) { const u32x4 a = xin[(ai * 4 + m) * 2 + bj];
                    const f32x4 v0 = (f32x4){bflo(a.x), bfhi(a.x), bflo(a.y), bfhi(a.y)} + acc[ai][bj][m][0], v1 = (f32x4){bflo(a.z), bfhi(a.z), bflo(a.w), bfhi(a.w)} + acc[ai][bj][m][1];
                    acc[ai][bj][m][0] = v0; acc[ai][bj][m][1] = v1;
                    ss += (v0[0] * v0[0] + v0[1] * v0[1]) + (v0[2] * v0[2] + v0[3] * v0[3]) + (v1[0] * v1[0] + v1[1] * v1[1]) + (v1[2] * v1[2] + v1[3] * v1[3]); }
                ss += __shfl_xor(ss, 16); ss += __shfl_xor(ss, 32);
                if (fq == 0) PARTF[((size_t)u.pn * S + row) * 4 + wc] = ss; }
        asm volatile("s_waitcnt vmcnt(0)" ::: "memory");
        __builtin_amdgcn_s_barrier();
        if (wr == 0 && wc == 0) { if (lane_id_v() == 0) {
            __builtin_amdgcn_fence(__ATOMIC_RELEASE, "agent");
            asm volatile("s_waitcnt vmcnt(0)" ::: "memory");
            xb_add(CNT + 64 * u.pm, 1u);
            XB_SPIN(xb_ld(CNT + 64 * u.pm) < 4u, tmo - XB_TMO);
            __builtin_amdgcn_fence(__ATOMIC_ACQUIRE, "agent");
            asm volatile("s_waitcnt vmcnt(0)" ::: "memory");
        } }
        __builtin_amdgcn_s_barrier();
        asm volatile("" ::: "memory");
        f32x4 gv[2][2];
#pragma unroll
        for (int bj = 0; bj < 2; ++bj)
#pragma unroll
            for (int n = 0; n < 2; ++n) gv[bj][n] = *(const f32x4*)(gfin + col0 + bj * 128 + 4 * n);
#pragma unroll
        for (int ai = 0; ai < 2; ++ai)
#pragma unroll
            for (int m = 0; m < 4; ++m) { const size_t row = (size_t)(row0 + ai * 128 + m * 16);
                const f32x4 p0 = *(const f32x4*)(PARTF + ((size_t)0 * S + row) * 4), p1 = *(const f32x4*)(PARTF + ((size_t)1 * S + row) * 4),
                            p2 = *(const f32x4*)(PARTF + ((size_t)2 * S + row) * 4), p3 = *(const f32x4*)(PARTF + ((size_t)3 * S + row) * 4);
                const f32x4 t = (p0 + p1) + (p2 + p3);
                const float rstd = __builtin_amdgcn_rsqf(((t[0] + t[1]) + (t[2] + t[3])) * (1.f / D) + EPS);
#pragma unroll
                for (int bj = 0; bj < 2; ++bj) { float* op = OUT + row * D + col0 + bj * 128;
                    *(f32x4*)op = acc[ai][bj][m][0] * gv[bj][0] * rstd; *(f32x4*)(op + 4) = acc[ai][bj][m][1] * gv[bj][1] * rstd; } }
    }
};

#ifdef DIAG
DI float bfv(const bf16_t* p) { return __builtin_bit_cast(float, (unsigned)(*p) << 16); }
DI float dotbb(const bf16_t* a, const bf16_t* b, int n) { float s = 0.f; for (int k = 0; k < n; ++k) s += bfv(a + k) * bfv(b + k); return s; }
DI unsigned hsh(unsigned x) { x ^= x >> 16; x *= 0x7feb352du; x ^= x >> 15; x *= 0x846ca68bu; x ^= x >> 16; return x; }
DI int srow(int tid) { return tid < 64 ? ((tid & 7) + 126 * (tid >> 3)) : (tid < 80 ? S - 1 - (tid - 64) : (int)(hsh(tid) % S)); }
DI void chk(unsigned* dg, int code, float got, float exp, float rel, float abs_) { if (!(fabsf(got - exp) <= rel * fabsf(exp) + abs_)) atomicMin(dg, (unsigned)code); }
#define DCHK(code, got, exp, rel, abs_) chk(dg, code, got, exp, rel, abs_)
#endif

struct Args { const float* in[20]; float* out; unsigned char* ws; int ph_lo, ph_hi; };

__global__ void __launch_bounds__(NWAVES * 64, 2) fwd_kernel(Args args) {
    extern __shared__ __attribute__((aligned(16))) unsigned char lds_raw[];
    LAS unsigned char* lds = (LAS unsigned char*)lds_raw;
    cg::grid_group grid = cg::this_grid();
    const int wave = __builtin_amdgcn_readfirstlane((int)threadIdx.x >> 6);
    const int G = gridDim.x, bx = blockIdx.x;
    const int vcu = (G % 8 == 0) ? (bx % 8) * (G / 8) + bx / 8 : bx;
    unsigned char* ws = args.ws;
    const float* x = args.in[0]; const float* mem = args.in[1]; const float* g_mix = args.in[2]; const float* g_mem = args.in[3];
    const float* w_in = args.in[4]; const float* b_gate = args.in[5]; const float* w_pool = args.in[6]; const float* pool_scale = args.in[7];
    const float* rel_bias = args.in[8]; const float* w_mem_kv = args.in[9]; const float* w_up_pool = args.in[10]; const float* w_up_attn = args.in[11];
    const float* w_up_mem = args.in[12]; const float* w_out = args.in[13]; const float* g_ffn = args.in[14]; const float* w_ffn_up = args.in[15];
    const float* conv_w = args.in[16]; const float* conv_b = args.in[17]; const float* w_ffn_down = args.in[18]; const float* g_final = args.in[19];
    float* out = args.out;
    bf16_t* WIN = (bf16_t*)(ws + WS_WIN); bf16_t* WUP = (bf16_t*)(ws + WS_WUP); bf16_t* WOUT = (bf16_t*)(ws + WS_WOUT); bf16_t* WFUP = (bf16_t*)(ws + WS_WFUP); bf16_t* WDN = (bf16_t*)(ws + WS_WDN);
    bf16_t* KM = (bf16_t*)(ws + WS_KM); bf16_t* VMT = (bf16_t*)(ws + WS_VMT); float* PART = (float*)(ws + WS_PART); float* PART2 = (float*)(ws + WS_PART2);
    bf16_t* R1 = (bf16_t*)(ws + WS_R1); bf16_t* QKU = (bf16_t*)(ws + WS_QKU); bf16_t* GATES = (bf16_t*)(ws + WS_GATES); bf16_t* VTb = (bf16_t*)(ws + WS_VT); bf16_t* KFb = (bf16_t*)(ws + WS_KF);
    bf16_t* MERGED = (bf16_t*)(ws + WS_MERGED); bf16_t* ACT = (bf16_t*)(ws + WS_ACT);
    const int lo = args.ph_lo, hi = args.ph_hi;
#define IN(k) (lo <= (k) && (k) < hi)
#ifdef REPEAT_PHASE
#define REP(k) (((k) == REPEAT_PHASE) ? 2 : 1)
#else
#define REP(k) 1
#endif
#ifdef DELAY_PHASE
#define PH_T0(k) const unsigned long long _pt0_##k = ((k) == DELAY_PHASE) ? rt_v() : 0ull
#define PH_T1(k) do { if ((k) == DELAY_PHASE) { const unsigned long long _t1 = rt_v(); while (rt_v() < _t1 + (_t1 - _pt0_##k)) __builtin_amdgcn_s_sleep(8); } } while (0)
#else
#define PH_T0(k)
#define PH_T1(k)
#endif
    unsigned* barw = (unsigned*)(ws + WS_BAR);
    volatile LAS unsigned* bst = (volatile LAS unsigned*)(lds + LDS_MISC);
    if (wave == 0) { if (lane_id_v() == 0) { bst[0] = 0u; bst[1] = 0u; } }
#define GBAR() grid_bar(barw, bst, (unsigned)G, wave)
#ifdef DIAG
#define GSYNC0() do { grid.sync(); if (wave == 0) { if (lane_id_v() == 0) (void)xb_add(&barw[XB_XCNT(xb_xcc_id())], 1u); } } while (0)
#else
    if (lo == 0 && hi > 1) {
        unsigned* ready = barw + 12288; const int tid0 = wave * 64 + lane_id_v();
        if (bx == 0) {
            for (int i = tid0; i < 4160 + 64 * 64; i += 512) __hip_atomic_store(barw + i, 0u, __ATOMIC_RELAXED, __HIP_MEMORY_SCOPE_AGENT);
            asm volatile("s_waitcnt vmcnt(0)" ::: "memory");
            __syncthreads();
            if (tid0 == 0) { __builtin_amdgcn_fence(__ATOMIC_RELEASE, "agent"); asm volatile("s_waitcnt vmcnt(0)" ::: "memory");
                (void)__hip_atomic_exchange(ready, 0x600DF00Du, __ATOMIC_RELAXED, __HIP_MEMORY_SCOPE_AGENT); }
        } else if (tid0 == 0) {
            unsigned sp = 0; while (xb_ld(ready) != 0x600DF00Du) { __builtin_amdgcn_s_sleep(1); if (++sp > XB_SPIN_CAP) break; }
            __builtin_amdgcn_fence(__ATOMIC_ACQUIRE, "agent"); asm volatile("s_waitcnt vmcnt(0)" ::: "memory");
        }
        __syncthreads();
        if (tid0 == 0) (void)xb_add(&barw[XB_XCNT(xb_xcc_id())], 1u);
    }
    if (args.ph_lo < 0) grid.sync();
#define GSYNC0() GBAR()
#endif
#if defined(DELAY_PHASE) && DELAY_PHASE == 8
#define SEAM(k) do { if (IN(k) && IN((k) + 1)) { const unsigned long long _b0 = rt_v(); if ((k) == 0) GSYNC0(); else GBAR(); const unsigned long long _b1 = rt_v(); while (rt_v() < _b1 + (_b1 - _b0)) __builtin_amdgcn_s_sleep(8); } } while (0)
#elif defined(DOUBLE_BAR)
#define SEAM(k) do { if (IN(k) && IN((k) + 1)) { if ((k) == 0) GSYNC0(); else GBAR(); GBAR(); } } while (0)
#else
#define SEAM(k) do { if (IN(k) && IN((k) + 1)) { if ((k) == 0) GSYNC0(); else GBAR(); } } while (0)
#endif

    PH_T0(0);
    for (int rep = 0; rep < REP(0); ++rep) if (IN(0)) {
        const int lane = lane_id_v(), tid = wave * 64 + lane;
        LAS float* scr = (LAS float*)(lds + wave * 16384);
        const int gw = wave * G + vcu, NGW = G * NWAVES;
        if (bx == 0) { for (int i = tid; i < 1024; i += 512) ((unsigned*)(ws + WS_R1 - 4096))[i] = 0u;
#ifdef DIAG
            for (int i = tid; i < 4160 + 64 * 64; i += 512) __hip_atomic_store(barw + i, (i == 4096) ? 0x7fffffffu : 0u, __ATOMIC_RELAXED, __HIP_MEMORY_SCOPE_AGENT);
#endif

            if (false) __hip_atomic_store(barw + 4096, 0x7fffffffu, __ATOMIC_RELAXED, __HIP_MEMORY_SCOPE_AGENT); }
        constexpr int I_MKV = 128, I_WP = 512;
        constexpr int I_IN = 16 * 160, I_UA = 8 * 32, I_UM = 4 * 32, I_WO = 16 * 32, I_FU = 16 * 176, I_FD = 44 * 32;
        constexpr int I_ROWS = S / 2;
        constexpr int NITEMS = I_WP + I_IN + I_UA + I_UM + I_WO + I_FU + I_FD + I_ROWS;
        if (vcu < I_MKV) {
            const int nb = vcu >> 3, mb = vcu & 7, rr = lane & 31, gg = lane >> 5; const int n0 = 32 * nb, m0 = 32 * mb;
            f32x16 acc; for (int i = 0; i < 16; ++i) acc[i] = 0.f;
            float ss = 0.f;
            const float* mrow = mem + (size_t)(m0 + rr) * D;
#pragma unroll 8
            for (int k0 = 128 * wave; k0 < 128 * wave + 128; k0 += 16) { const int kk = k0 + 8 * gg;
                const f32x4 a0 = *(const f32x4*)(mrow + kk), a1 = *(const f32x4*)(mrow + kk + 4), g0 = *(const f32x4*)(g_mem + kk), g1 = *(const f32x4*)(g_mem + kk + 4);
                ss += (a0[0] * a0[0] + a0[1] * a0[1]) + (a0[2] * a0[2] + a0[3] * a0[3]) + (a1[0] * a1[0] + a1[1] * a1[1]) + (a1[2] * a1[2] + a1[3] * a1[3]);
                const bf16x8 bfr = __builtin_bit_cast(bf16x8, pack8(a0 * g0, a1 * g1));
                float wv[8];
#pragma unroll
                for (int j = 0; j < 8; ++j) wv[j] = w_mem_kv[(size_t)(kk + j) * 512 + n0 + rr];
                u32x4 wa; wa.x = pk2(wv[0], wv[1]); wa.y = pk2(wv[2], wv[3]); wa.z = pk2(wv[4], wv[5]); wa.w = pk2(wv[6], wv[7]);
                acc = MFMA32(__builtin_bit_cast(bf16x8, wa), bfr, acc); }
#pragma unroll
            for (int i = 0; i < 16; ++i) scr[i * 64 + lane] = acc[i];
            scr[1024 + lane] = ss;
            __syncthreads();
            if (wave == 0) {
#pragma unroll
                for (int w = 1; w < 8; ++w) { const LAS float* pw = (const LAS float*)(lds + w * 16384);
#pragma unroll
                    for (int i = 0; i < 16; ++i) acc[i] += pw[i * 64 + lane];
                    ss += pw[1024 + lane]; }
                ss += __shfl_xor(ss, 32);
                const float rstd = __builtin_amdgcn_rsqf(ss * (1.f / D) + EPS);
                const int mI = m0 + rr;
                if (n0 < 256) {
#pragma unroll
                    for (int ig = 0; ig < 4; ++ig) { u32x2 w; w.x = pk2(acc[4 * ig] * rstd, acc[4 * ig + 1] * rstd); w.y = pk2(acc[4 * ig + 2] * rstd, acc[4 * ig + 3] * rstd);
                        *(u32x2*)(KM + kf_elem(8, n0 >> 6, mI, (n0 & 63) + 8 * ig + 4 * gg)) = w; }
                } else {
#pragma unroll
                    for (int i = 0; i < 16; ++i) { const int nn = n0 - 256 + crow(i, gg); VMT[vf_elem(8, nn >> 6, mI, nn & 63)] = (bf16_t)(pk2(acc[i] * rstd, 0.f) & 0xffffu); }
                }
            }
            __syncthreads();
        }
        for (int it = gw; it < NITEMS; it += NGW) {
            int r = it;
            if (r < I_WP) {
                const int gI = r >> 7, c0 = ((r >> 4) & 7) * 8, n = (r & 15) * 64 + lane;
                float a[8]; for (int i = 0; i < 8; ++i) a[i] = 0.f;
#pragma unroll 64
                for (int d = 0; d < 64; ++d) { const float wv = w_up_pool[(size_t)(gI * 64 + d) * D + n] * pool_scale[gI * 64 + d];
#pragma unroll
                    for (int ci = 0; ci < 8; ++ci) a[ci] += w_pool[(size_t)((gI * 64 + c0 + ci) * 64) + d] * wv; }
                u32x4 w; w.x = pk2(a[0], a[1]); w.y = pk2(a[2], a[3]); w.z = pk2(a[4], a[5]); w.w = pk2(a[6], a[7]);
                *(u32x4*)(WUP + (size_t)n * D + gI * 64 + c0) = w;
                continue; } r -= I_WP;
            if (r < I_IN + I_UA + I_UM + I_WO + I_FU + I_FD) {
                const float* W; int N, ldt = D, koff = 0, ro = 0, kb, nb; bf16_t* WT; const float* ks = nullptr;
                if (r < I_IN) { kb = r / 160; nb = r % 160; const int n0 = 32 * nb;
                    ro = (n0 < 1280) ? 0 : (n0 < 1792) ? (4608 - 1280) : -512; W = w_in; N = NIN; WT = WIN; }
                else if ((r -= I_IN) < I_UA) { kb = r / 32; nb = r % 32; W = w_up_attn; N = D; WT = WUP; koff = 256; }
                else if ((r -= I_UA) < I_UM) { kb = r / 32; nb = r % 32; W = w_up_mem; N = D; WT = WUP; koff = 768; }
                else if ((r -= I_UM) < I_WO) { kb = r / 32; nb = r % 32; W = w_out; N = D; WT = WOUT; }
                else if ((r -= I_WO) < I_FU) { kb = r / 176; nb = r % 176; W = w_ffn_up; N = 2 * DFF; WT = WFUP; ks = g_ffn; }
                else { r -= I_FU; kb = r / 32; nb = r % 32; W = w_ffn_down; N = D; WT = WDN; ldt = DFF; }
                transpose_item(W, N, WT, ldt, koff, ro, ks, scr, kb, nb, lane); continue; }
            r -= I_IN + I_UA + I_UM + I_WO + I_FU + I_FD;
            {
                const f32x4* xr = (const f32x4*)(x + (size_t)(2 * r) * D) + lane; const f32x4* gr = (const f32x4*)g_mix + lane;
                f32x4 v[8]; float s0 = 0.f, s1 = 0.f;
#pragma unroll
                for (int j = 0; j < 8; ++j) v[j] = __builtin_nontemporal_load(xr + 64 * j);
#pragma unroll
                for (int j = 0; j < 4; ++j) { s0 += (v[j][0] * v[j][0] + v[j][1] * v[j][1]) + (v[j][2] * v[j][2] + v[j][3] * v[j][3]);
                    s1 += (v[4 + j][0] * v[4 + j][0] + v[4 + j][1] * v[4 + j][1]) + (v[4 + j][2] * v[4 + j][2] + v[4 + j][3] * v[4 + j][3]); }
                const float rstd0 = __builtin_amdgcn_rsqf(wave_sum(s0) * (1.f / D) + EPS), rstd1 = __builtin_amdgcn_rsqf(wave_sum(s1) * (1.f / D) + EPS);
                u32x2* o8 = (u32x2*)(R1 + (size_t)(2 * r) * D) + lane;
#pragma unroll
                for (int j = 0; j < 8; ++j) { const f32x4 gg = gr[64 * (j & 3)]; const float rs = (j < 4) ? rstd0 : rstd1;
                    u32x2 w; w.x = pk2(v[j][0] * rs * gg[0], v[j][1] * rs * gg[1]); w.y = pk2(v[j][2] * rs * gg[2], v[j][3] * rs * gg[3]); o8[64 * j] = w; }
            }
        }
    }
    PH_T1(0);
    SEAM(0);
#ifdef DIAG
    unsigned* dg = (unsigned*)(ws + WS_BAR + 16384);
    if (bx == 0) { const int tid = wave * 64 + lane_id_v(); const unsigned h = hsh(tid * 7 + 1);
        { const int n = h % NIN, k = (h >> 13) % D; const int np = (n < 1280) ? n : (n < 1792) ? n + 3328 : n - 512; DCHK(11, bfv(WIN + (size_t)np * D + k), w_in[(size_t)k * NIN + n], 0.01f, 1e-4f); }
        { const int n = h % D, k = (h >> 13) % 512; DCHK(12, bfv(WUP + (size_t)n * D + 256 + k), w_up_attn[(size_t)k * D + n], 0.01f, 1e-4f); }
        { const int n = h % D, k = (h >> 13) % 256; DCHK(13, bfv(WUP + (size_t)n * D + 768 + k), w_up_mem[(size_t)k * D + n], 0.01f, 1e-4f); }
        { const int n = h % D, gc = (h >> 13) % 256, gI = gc >> 6; float e = 0.f; for (int d = 0; d < 64; ++d) e += w_pool[(size_t)gc * 64 + d] * pool_scale[gI * 64 + d] * w_up_pool[(size_t)(gI * 64 + d) * D + n];
          DCHK(14, bfv(WUP + (size_t)n * D + gc), e, 0.01f, 1e-3f); }
        { const int n = h % D, k = (h >> 13) % D; DCHK(15, bfv(WOUT + (size_t)n * D + k), w_out[(size_t)k * D + n], 0.01f, 1e-4f); }
        { const int n = h % (2 * DFF), k = (h >> 13) % D; DCHK(16, bfv(WFUP + (size_t)n * D + k), w_ffn_up[(size_t)k * 2 * DFF + n] * g_ffn[k], 0.01f, 1e-4f); }
        { const int n = h % D, k = (h >> 13) % DFF; DCHK(17, bfv(WDN + (size_t)n * DFF + k), w_ffn_down[(size_t)k * D + n], 0.01f, 1e-4f); }
        { const int m = h % 256, n = (h >> 13) % 512; float ss = 0.f, e = 0.f; for (int k = 0; k < D; ++k) { const float a = mem[(size_t)m * D + k]; ss += a * a; e += a * g_mem[k] * w_mem_kv[(size_t)k * 512 + n]; }
          e *= 1.f / sqrtf(ss / D + EPS); const float got = (n < 256) ? bfv(KM + kf_elem(8, n >> 6, m, n & 63)) : bfv(VMT + vf_elem(8, (n - 256) >> 6, m, (n - 256) & 63)); DCHK(18, got, e, 0.02f, 5e-3f); }
        { const int r = srow(tid), c = (h >> 7) % D; float ss = 0.f; for (int k = 0; k < D; ++k) { const float a = x[(size_t)r * D + k]; ss += a * a; }
          DCHK(19, bfv(R1 + (size_t)r * D + c), x[(size_t)r * D + c] / sqrtf(ss / D + EPS) * g_mix[c], 0.01f, 1e-3f); }
        if (tid < 1024) DCHK(10, bfv(R1 - 2 * D + tid) + bfv(R1 - 2 * D + tid + 512) + bfv(R1 - 2 * D + tid + 1024) + bfv(R1 - 2 * D + tid + 1536), 0.f, 0.f, 0.f);
    }
    GBAR();
#endif
    PH_T0(1);
    for (int rep = 0; rep < REP(1); ++rep) if (IN(1)) {
        { pg8::Gemm g{R1, WIN, D, (size_t)256 * D * 2, (size_t)128 * D * 2, (size_t)256 * D * 2, (size_t)128 * D * 2};
          pg8::StaticOrder So; So.init(S / 256, 18, G, bx); EpiIn E{QKU, GATES, b_gate, KFb};
          pg8::gemm_phase<EpiIn, pg8::StaticOrder>(lds, g, So, E, wave); }
        { pg8::Gemm g{WIN + (size_t)4608 * D, R1, D, (size_t)256 * D * 2, (size_t)128 * D * 2, (size_t)256 * D * 2, (size_t)128 * D * 2};
          pg8::StaticOrder So; So.init(2, S / 256, G, (bx + G / 2) % G); EpiVT E{VTb};
          pg8::gemm_phase<EpiVT, pg8::StaticOrder>(lds, g, So, E, wave); }
    }
    PH_T1(1);
    SEAM(1);
#ifdef DIAG
    if (bx == 0) { const int tid = wave * 64 + lane_id_v(); const unsigned h = hsh(tid * 11 + 3); const int r = srow(tid);
        { const int c = h % 4608; float e = dotbb(R1 + (size_t)r * D, WIN + (size_t)c * D, D);
          if (c < 1536) { if ((c >= 256 && c < 768) || c >= 1280) e *= QSCALE; const float got = (c >= 768 && c < 1280) ? bfv(KFb + kf_elem(512, (c - 768) >> 6, r, (c - 768) & 63)) : bfv(QKU + (size_t)r * QKU_P + c); DCHK(21 + (c >= 256) + (c >= 768) + (c >= 1280), got, e, 0.02f, 0.02f); }
          else { e = 1.f / (1.f + expf(-(e + b_gate[c - 1536]))); DCHK(25, bfv(GATES + (size_t)r * GATE_P + c - 1536), e, 0.02f, 0.01f); } }
        { const int c = h % 512; const float e = dotbb(R1 + (size_t)r * D, WIN + (size_t)(4608 + c) * D, D); DCHK(26, bfv(VTb + vf_elem(512, c >> 6, r, c & 63)), e, 0.02f, 0.02f); }
    }
    GBAR();
#endif
    PH_T0(2);
    for (int rep = 0; rep < REP(2); ++rep) if (IN(2)) {
        const int lane = lane_id_v(), tid = wave * 64 + lane;
        LAS float* bl = (LAS float*)(lds + LDS_BIAS);
        for (int i = tid; i < 8 * 321; i += 512) { const int hh = i / 321, j = i % 321; bl[i] = rel_bias[hh * 257 + (j > 256 ? 256 : j)] * LOG2E; }
        __syncthreads();
        bf16_t* OCAT = R1;
        for (int c = vcu; c < S / 64; c += G) {
            { const int jtmin = (c >= 8) ? 0 : 8 - c; const int tok0 = 64 * (c - 8 + jtmin);
              attn_wave(QKU + (size_t)64 * c * QKU_P + 256 + 64 * wave, QKU_P, KFb + kf_elem(512, wave, tok0, 0), VTb + vf_elem(512, wave, tok0, 0),
                        2 * (9 - jtmin), jtmin, bl + wave * 321, true, OCAT + (size_t)64 * c * D + 256 + 64 * wave, D, lane, lds + wave * 8192); }
            if (wave < 4) {
                attn_wave(QKU + (size_t)64 * c * QKU_P + 1280 + 64 * wave, QKU_P, KM + kf_elem(8, wave, 0, 0), VMT + vf_elem(8, wave, 0, 0), 8, 0,
                          bl, false, OCAT + (size_t)64 * c * D + 768 + 64 * wave, D, lane, lds + wave * 8192);
            } else {
                const int gI = wave - 4, ch = gI * 64 + (lane & 7) * 8, t0 = 64 * c + (lane >> 3) * 8;
                const bf16_t* U = QKU + ch; bf16_t* OC = OCAT + ch;
                if (gI == 0) pool_lane<2>(U, OC, t0); else if (gI == 1) pool_lane<4>(U, OC, t0); else if (gI == 2) pool_lane<8>(U, OC, t0); else pool_lane<16>(U, OC, t0);
            }
        }
    }
    PH_T1(2);
    SEAM(2);
#ifdef DIAG
    if (bx == 0) { const int tid = wave * 64 + lane_id_v(); const unsigned h = hsh(tid * 13 + 5); const int t = srow(tid);
        { const int ch = h % 256, gI = ch >> 6, win = 2 << gI; float sm = 0.f; for (int i = 0; i < win; ++i) if (t - i >= 0) sm += bfv(QKU + (size_t)(t - i) * QKU_P + ch);
          const float e = sm / (float)((t + 1 < win) ? t + 1 : win) - bfv(QKU + (size_t)t * QKU_P + ch); DCHK(31, bfv(R1 + (size_t)t * D + ch), e, 0.02f, 0.02f); }
        { const int hh = (h >> 8) % 8, d = (h >> 12) % 64, c = t >> 6; float mx = -1e30f, den = 0.f, num = 0.f;
          for (int pass = 0; pass < 2; ++pass) for (int j = 0; j < 576; ++j) { const int kt = 64 * (c - 8) + j; if (kt < 0) continue;
              float sc = 0.f; for (int dd = 0; dd < 64; ++dd) sc += bfv(QKU + (size_t)t * QKU_P + 256 + 64 * hh + dd) * bfv(KFb + kf_elem(512, hh, kt, dd));
              int rel = t - kt; rel = rel > 128 ? 128 : (rel < -128 ? -128 : rel); sc += rel_bias[hh * 257 + rel + 128] * LOG2E;
              if (pass == 0) mx = fmaxf(mx, sc); else { const float p = exp2f(sc - mx); den += p; num += p * bfv(VTb + vf_elem(512, hh, kt, d)); } }
          DCHK(32, bfv(R1 + (size_t)t * D + 256 + 64 * hh + d), num / den, 0.03f, 0.01f); }
        { const int hh = (h >> 8) % 4, d = (h >> 12) % 64; float mx = -1e30f, den = 0.f, num = 0.f;
          for (int pass = 0; pass < 2; ++pass) for (int j = 0; j < 256; ++j) { float sc = 0.f; for (int dd = 0; dd < 64; ++dd) sc += bfv(QKU + (size_t)t * QKU_P + 1280 + 64 * hh + dd) * bfv(KM + kf_elem(8, hh, j, dd));
              if (pass == 0) mx = fmaxf(mx, sc); else { const float p = exp2f(sc - mx); den += p; num += p * bfv(VMT + vf_elem(8, hh, j, d)); } }
          DCHK(33, bfv(R1 + (size_t)t * D + 768 + 64 * hh + d), num / den, 0.03f, 0.01f); }
    }
    GBAR();
#endif
    PH_T0(3);
    for (int rep = 0; rep < REP(3); ++rep) if (IN(3)) {
        pg8::Gemm g{R1, WUP, D, (size_t)256 * D * 2, (size_t)128 * D * 2, (size_t)256 * D * 2, (size_t)128 * D * 2};
        pg8::StaticOrder So; So.init(S / 256, 4, G, bx); EpiMerge E{GATES, MERGED};
        pg8::gemm_phase<EpiMerge, pg8::StaticOrder>(lds, g, So, E, wave);
    }
    PH_T1(3);
    SEAM(3);
#ifdef DIAG
    if (bx == 0) { const int tid = wave * 64 + lane_id_v(); const unsigned h = hsh(tid * 17 + 7); const int r = srow(tid), c = h % D;
        const float y0 = dotbb(R1 + (size_t)r * D, WUP + (size_t)c * D, 256), y1 = dotbb(R1 + (size_t)r * D + 256, WUP + (size_t)c * D + 256, 512), y2 = dotbb(R1 + (size_t)r * D + 768, WUP + (size_t)c * D + 768, 256);
        const float e = bfv(GATES + (size_t)r * GATE_P + c) * y0 + bfv(GATES + (size_t)r * GATE_P + D + c) * y1 + bfv(GATES + (size_t)r * GATE_P + 2 * D + c) * y2;
        DCHK(41, bfv(MERGED + (size_t)r * D + c), e, 0.03f, 0.02f); }
    GBAR();
#endif
    PH_T0(4);
    for (int rep = 0; rep < REP(4); ++rep) if (IN(4)) {
        pg8::Gemm g{MERGED, WOUT, D, (size_t)256 * D * 2, (size_t)128 * D * 2, (size_t)256 * D * 2, (size_t)128 * D * 2};
        pg8::StaticOrder So; So.init(S / 256, 4, G, bx); EpiResid<false> E{x, R1, PART};
        pg8::gemm_phase<EpiResid<false>, pg8::StaticOrder>(lds, g, So, E, wave);
    }
    PH_T1(4);
    SEAM(4);
#ifdef DIAG
    if (bx == 0) { const int tid = wave * 64 + lane_id_v(); const unsigned h = hsh(tid * 19 + 9); const int r = srow(tid), c = h % D;
        const float e = x[(size_t)r * D + c] + dotbb(MERGED + (size_t)r * D, WOUT + (size_t)c * D, D);
        DCHK(52, bfv(R1 + (size_t)r * D + c), e, 0.02f, 0.02f);
        float ss = 0.f, ps = 0.f; for (int k = 0; k < D; ++k) { const float a = bfv(R1 + (size_t)r * D + k); ss += a * a; } for (int k = 0; k < 16; ++k) ps += PART[(size_t)r * 16 + k];
        DCHK(53, ps, ss, 0.01f, 0.f); }
    GBAR();
#endif
    PH_T0(5);
    for (int rep = 0; rep < REP(5); ++rep) if (IN(5)) {
        pg8::Gemm g{R1 - 2 * D, WFUP, D, (size_t)252 * D * 2, (size_t)4 * D * 2, (size_t)128 * D * 2, (size_t)DFF * D * 2};
        pg8::StaticOrder So; So.init(66, 22, G, bx);
        LAS float* RS = (LAS float*)(lds + LDS_BIAS);
        { const int tid5 = wave * 64 + lane_id_v(), slot = tid5 & 255; Unit uu;
          for (int i = tid5 >> 8; i < 8 && So.next(i, uu); i += 2) { const int row = 252 * uu.pm - 2 + 126 * (slot >> 7) + (slot & 127); float v = 0.f;
              if (row >= 0 && row < S) { const f32x4* p = (const f32x4*)(PART + (size_t)row * 16); const f32x4 t = (p[0] + p[1]) + (p[2] + p[3]);
                  v = __builtin_amdgcn_rsqf(((t[0] + t[1]) + (t[2] + t[3])) * (1.f / D) + EPS); }
              RS[i * 256 + slot] = v; }
          __syncthreads(); }
        EpiFfnUp E{ACT, RS, conv_w, conv_b, (bf16_t*)(ws + WS_DUMP)};
        pg8::gemm_phase<EpiFfnUp, pg8::StaticOrder>(lds, g, So, E, wave);
    }
    PH_T1(5);
    SEAM(5);
#ifdef DIAG
    if (bx == 0) { const int tid = wave * 64 + lane_id_v(); const unsigned h = hsh(tid * 23 + 11); const int t = srow(tid), j = h % DFF;
        float cg = conv_b[j], cv = conv_b[DFF + j];
        for (int k = 0; k < 3; ++k) { const int tt = t - 2 + k; if (tt < 0) continue; float ps = 0.f; for (int q = 0; q < 16; ++q) ps += PART[(size_t)tt * 16 + q];
            const float rstd = 1.f / sqrtf(ps / D + EPS);
            cg += conv_w[(size_t)k * 2 * DFF + j] * rstd * dotbb(R1 + (size_t)tt * D, WFUP + (size_t)j * D, D);
            cv += conv_w[(size_t)k * 2 * DFF + DFF + j] * rstd * dotbb(R1 + (size_t)tt * D, WFUP + (size_t)(DFF + j) * D, D); }
        const float e = 0.5f * cg * (1.f + erff(cg * 0.70710678f)) * cv;
        DCHK(61 + ((tid < 64) ? (tid & 7) : 8), bfv(ACT + (size_t)t * DFF + j), e, 0.03f, 0.03f); }
    GBAR();
#endif
    PH_T0(6);
    const bool fuse_final = (G == 256);
    if (IN(6)) {
        pg8::Gemm g{ACT, WDN, DFF, (size_t)256 * DFF * 2, (size_t)128 * DFF * 2, (size_t)256 * DFF * 2, (size_t)128 * DFF * 2};
        pg8::StaticOrder So; So.init(S / 256, 4, G, bx);
        if (fuse_final) { EpiFinal E{R1, out, PART2, barw + 4160, g_final, barw + XB_TMO};
            pg8::gemm_phase<EpiFinal, pg8::StaticOrder>(lds, g, So, E, wave); }
        else { EpiResid<true> E{nullptr, R1, PART2};
            pg8::gemm_phase<EpiResid<true>, pg8::StaticOrder>(lds, g, So, E, wave); }
    }
    PH_T1(6);
    if (!fuse_final) SEAM(6);
    PH_T0(7);
    if (IN(7) && !fuse_final) {
        const int lane = lane_id_v();
        const int gw = vcu * NWAVES + wave, NGW = G * NWAVES;
        for (int r = gw; r < S; r += NGW) {
            const f32x4* p = (const f32x4*)(PART2 + (size_t)r * 16); const f32x4 t = (p[0] + p[1]) + (p[2] + p[3]);
            const float rstd = __builtin_amdgcn_rsqf(((t[0] + t[1]) + (t[2] + t[3])) * (1.f / D) + EPS);
            const u32x2* xr = (const u32x2*)(R1 + (size_t)r * D) + lane; const f32x4* gr = (const f32x4*)g_final + lane;
            f32x4* xw = (f32x4*)(out + (size_t)r * D) + lane;
#pragma unroll
            for (int j = 0; j < 4; ++j) { const u32x2 a = xr[64 * j]; const f32x4 v = {bflo(a.x), bfhi(a.x), bflo(a.y), bfhi(a.y)}; xw[64 * j] = v * gr[64 * j] * rstd; }
        }
    }
    PH_T1(7);
#ifdef DIAG
    GBAR();
    if (bx == 0 && wave == 0 && lane_id_v() == 0) { const unsigned code = __hip_atomic_load(dg, __ATOMIC_RELAXED, __HIP_MEMORY_SCOPE_AGENT); if (code != 0x7fffffffu) out[0] = 100.f * (float)code; }
#endif
#ifndef DIAG
    if (lo == 0 && hi > 1 && bx == 0 && wave == 0) { if (lane_id_v() == 0) (void)__hip_atomic_exchange(barw + 12288, 0u, __ATOMIC_RELAXED, __HIP_MEMORY_SCOPE_AGENT); }
#endif
#undef IN
#undef SEAM
}

#ifndef N_LAUNCHES
#define N_LAUNCHES 1
#endif
extern "C" void kernel_launch(void* const* d_in, const int* in_sizes, int n_in, void* d_out, int out_size, void* d_ws, size_t ws_size, hipStream_t stream) {
    static int grid = 0;
    if (grid == 0) {
        if (n_in != 20 || out_size != S * D || ws_size < WS_END) { fprintf(stderr, "kernel_launch: unexpected shapes (n_in %d out %d ws %zu)\n", n_in, out_size, ws_size); grid = -1; return; }
        int dev = 0, cus = 0, per_cu = 0;
        hipGetDevice(&dev); hipDeviceGetAttribute(&cus, hipDeviceAttributeMultiprocessorCount, dev);
        if (hipFuncSetAttribute((const void*)fwd_kernel, hipFuncAttributeMaxDynamicSharedMemorySize, LDS_BYTES) != hipSuccess) { fprintf(stderr, "kernel_launch: hipFuncSetAttribute failed\n"); grid = -1; return; }
        if (hipOccupancyMaxActiveBlocksPerMultiprocessor(&per_cu, (const void*)fwd_kernel, NWAVES * 64, LDS_BYTES) != hipSuccess || per_cu < 1) per_cu = 1;
        (void)hipGetLastError();
        grid = cus * per_cu; if (grid > 256) grid = 256;
        fprintf(stderr, "kernel_launch: grid %d (cus %d per_cu %d)\n", grid, cus, per_cu);
    }
    if (grid < 0) return;
    Args a{};
    for (int i = 0; i < 20; ++i) a.in[i] = (const float*)d_in[i];
    a.out = (float*)d_out; a.ws = (unsigned char*)d_ws;
#if N_LAUNCHES == 1
    a.ph_lo = 0; a.ph_hi = 8;
    void* kargs[] = {&a};
    hipError_t e = hipLaunchCooperativeKernel((const void*)fwd_kernel, dim3(grid), dim3(NWAVES * 64), kargs, LDS_BYTES, stream);
    if (e != hipSuccess) fprintf(stderr, "cooperative launch failed: %s (grid %d)\n", hipGetErrorString(e), grid);
#else
    for (int p = 0; p < 8; ++p) { a.ph_lo = p; a.ph_hi = p + 1; hipLaunchKernelGGL(fwd_kernel, dim3(grid), dim3(NWAVES * 64), LDS_BYTES, stream, a); }
#endif
}
```
